# Optimizing an MI355X kernel written in HIP

```python
import math
import jax, jax.numpy as jnp
from jax import lax
import numpy as np

D_MODEL = 2048
BATCH = 16
SEQ = 256
DEPTH = 2
DEC_BATCH = 8
DEC_SEQ = 1024
PAST_LEN = 512

GRID_W = 64
HEAD_DIM = 128
ATT_WIDTH = D_MODEL // 2
N_ATT_HEADS = ATT_WIDTH // HEAD_DIM
N_KV_HEADS = N_ATT_HEADS // 4
GQA_GROUP = N_ATT_HEADS // N_KV_HEADS
KV_WIDTH = N_KV_HEADS * HEAD_DIM
RET_WIDTH = D_MODEL // 4
N_RET_HEADS = RET_WIDTH // HEAD_DIM
HYENA_WIDTH = D_MODEL // 4
HYENA_ORDER = 2
MIX_WIDTH = ATT_WIDTH + RET_WIDTH + HYENA_WIDTH
SPLIT_SIZES = (ATT_WIDTH, KV_WIDTH, KV_WIDTH, RET_WIDTH, RET_WIDTH, RET_WIDTH, RET_WIDTH,
               (HYENA_ORDER + 1) * HYENA_WIDTH)
IN_WIDTH = ATT_WIDTH + 2 * KV_WIDTH + 4 * RET_WIDTH + (HYENA_ORDER + 1) * HYENA_WIDTH
D_FF = 5632
Q_BLOCK = 128
RET_CHUNK = 128
ROPE_THETA = 10000.0
FILTER_BANDS = 16
FILTER_EMB = 1 + 2 * FILTER_BANDS
FILTER_HID = 64
HYENA_DECAY_TARGET = 1e-2
HYENA_DECAY_PCT_MIN = 0.3
HYENA_DECAY_PCT_MAX = 1.5
DEEPNORM_ALPHA = (2 * DEPTH) ** 0.25
DEEPNORM_BETA = (8 * DEPTH) ** -0.25
EPS = 1e-6

kernel_name = 'hybrid_dit_attn_retention_hyena_step'


def _split_points(sizes):
    pts, acc = [], 0
    for s in sizes[:-1]:
        acc += s
        pts.append(acc)
    return pts


def layer_norm(x, w, b):
    xf = x.astype(jnp.float32)
    xc = xf - jnp.mean(xf, -1, keepdims=True)
    var = jnp.mean(xc * xc, -1, keepdims=True)
    return (xc * lax.rsqrt(var + EPS) * w.astype(jnp.float32) + b.astype(jnp.float32)).astype(x.dtype)


def head_norm(x):
    xf = x.astype(jnp.float32)
    xc = xf - jnp.mean(xf, -1, keepdims=True)
    var = jnp.mean(xc * xc, -1, keepdims=True)
    return (xc * lax.rsqrt(var + EPS)).astype(x.dtype)


def rms_norm(x, w):
    xf = x.astype(jnp.float32)
    return (xf * lax.rsqrt(jnp.mean(xf * xf, -1, keepdims=True) + EPS) * w.astype(jnp.float32)).astype(x.dtype)


def axial_rope_tables(n_tokens):
    rows = n_tokens // GRID_W
    row = jnp.repeat(jnp.arange(rows, dtype=jnp.float32), GRID_W)
    col = jnp.tile(jnp.arange(GRID_W, dtype=jnp.float32), rows)
    n_freq = HEAD_DIM // 4
    inv_freq = ROPE_THETA ** (-jnp.arange(n_freq, dtype=jnp.float32) / n_freq)
    ang = jnp.concatenate([row[:, None] * inv_freq[None], col[:, None] * inv_freq[None]], -1)
    return jnp.cos(ang), jnp.sin(ang)


def apply_rope(x, cos, sin):
    x1, x2 = jnp.split(x, 2, axis=-1)
    c = cos.astype(x.dtype)
    s = sin.astype(x.dtype)
    return jnp.concatenate([x1 * c - x2 * s, x1 * s + x2 * c], -1)


def centred_dwconv3(x, w):
    xp = jnp.pad(x, ((0, 0), (1, 1), (0, 0)))
    return xp[:, :-2] * w[0] + xp[:, 1:-1] * w[1] + xp[:, 2:] * w[2]


def block_attention(q, k, v):
    B, KV, G, Lq, hd = q.shape
    nb = Lq // Q_BLOCK
    qb = q.reshape(B, KV, G, nb, Q_BLOCK, hd).transpose(3, 0, 1, 2, 4, 5)
    scale = hd ** -0.5

    def one_block(qi):
        s = jnp.einsum('bkgqd,bksd->bkgqs', qi, k).astype(jnp.float32) * scale
        p = jax.nn.softmax(s, axis=-1).astype(v.dtype)
        return jnp.einsum('bkgqs,bksd->bkgqd', p, v)

    out = lax.map(one_block, qb)
    return out.transpose(1, 2, 3, 0, 4, 5).reshape(B, KV, G, Lq, hd)


def retention_scan(q, k, v, log_gamma, s0):
    B, H, L, d = q.shape
    C = RET_CHUNK
    n = L // C
    idx = jnp.arange(C, dtype=jnp.float32)
    lg = log_gamma[:, None]
    decay_q = jnp.exp(lg * (idx + 1.0))
    decay_k = jnp.exp(lg * (C - 1.0 - idx))
    diff = idx[:, None] - idx[None, :]
    dmat = jnp.where(diff >= 0, jnp.exp(lg[:, :, None] * jnp.maximum(diff, 0.0)), 0.0)
    chunk_decay = jnp.exp(log_gamma * C)
    qc = q.reshape(B, H, n, C, d)
    kc = k.reshape(B, H, n, C, d)
    vc = v.reshape(B, H, n, C, d)
    inner = jnp.einsum('bhnid,bhnjd->bhnij', qc, kc) * dmat[None, :, None].astype(q.dtype)
    inner_out = jnp.einsum('bhnij,bhnje->bhnie', inner, vc)
    kv = jnp.einsum('bhnjd,bhnje->bhnde', kc * decay_k[None, :, None, :, None].astype(q.dtype), vc)
    kv = kv.astype(jnp.float32).transpose(2, 0, 1, 3, 4)

    def step(s, kv_n):
        return chunk_decay[None, :, None, None] * s + kv_n, s

    s_final, s_prev = lax.scan(step, s0.astype(jnp.float32), kv)
    s_prev = s_prev.transpose(1, 2, 0, 3, 4)
    cross = jnp.einsum('bhnid,bhnde->bhnie', qc.astype(jnp.float32) * decay_q[None, :, None, :, None], s_prev)
    out = (inner_out.astype(jnp.float32) + cross).reshape(B, H, L, d)
    return out.astype(q.dtype), s_final.astype(q.dtype)


def hyena_filters(L, w1, b1, freq, w2, b2, w3):
    pos = jnp.arange(L, dtype=jnp.float32)
    t = pos / max(L - 1, 1)
    w = 2.0 * math.pi * pos / L
    f = jnp.linspace(1e-4, FILTER_BANDS - 1, FILTER_BANDS, dtype=jnp.float32)
    ang = w[:, None] * f[None, :]
    z = jnp.concatenate([t[:, None], jnp.cos(ang), -jnp.sin(ang)], -1).astype(w1.dtype)
    hdn = jnp.sin(freq * (z @ w1 + b1))
    hdn = jnp.sin(freq * (hdn @ w2 + b2))
    h = hdn @ w3
    deltas = jnp.linspace(math.log(HYENA_DECAY_TARGET) / HYENA_DECAY_PCT_MIN,
                          math.log(HYENA_DECAY_TARGET) / HYENA_DECAY_PCT_MAX, HYENA_WIDTH, dtype=jnp.float32)
    decay = jnp.exp(-t[:, None] * jnp.abs(deltas)[None, :]).astype(h.dtype)
    return h.reshape(L, HYENA_ORDER, 2, HYENA_WIDTH) * decay[:, None, None, :]


def centred_long_conv(u, h_fwd, h_bwd):
    L = u.shape[1]
    taps = jnp.concatenate([h_fwd, h_bwd[::-1]], 0)
    U = jnp.fft.rfft(u.astype(jnp.float32), n=2 * L, axis=1)
    K = jnp.fft.rfft(taps.astype(jnp.float32), n=2 * L, axis=0)
    y = jnp.fft.irfft(U * K[None], n=2 * L, axis=1)[:, :L]
    return y.astype(u.dtype)


def mixing(h, lp, rope, ctx_k, ctx_v, ret_init):
    B, L, _ = h.shape
    proj = h @ lp['w_in']
    q, k, v, rq, rk, rv, rg, hy = jnp.split(proj, _split_points(SPLIT_SIZES), axis=-1)

    q = rms_norm(q.reshape(B, L, N_KV_HEADS, GQA_GROUP, HEAD_DIM).transpose(0, 2, 3, 1, 4), lp['q_norm'])
    k = rms_norm(k.reshape(B, L, N_KV_HEADS, HEAD_DIM).transpose(0, 2, 1, 3), lp['k_norm'])
    v = v.reshape(B, L, N_KV_HEADS, HEAD_DIM).transpose(0, 2, 1, 3)
    own_k, own_v = k, v
    if rope is not None:
        cos, sin = rope
        q = apply_rope(q, cos, sin)
        k = apply_rope(k, cos, sin)
    if ctx_k is not None:
        k = jnp.concatenate([ctx_k, k], axis=2)
        v = jnp.concatenate([ctx_v, v], axis=2)
    att = block_attention(q, k, v).transpose(0, 3, 1, 2, 4).reshape(B, L, ATT_WIDTH)

    def heads(t):
        return t.reshape(B, L, N_RET_HEADS, HEAD_DIM).transpose(0, 2, 1, 3)
    rq_, rk_, rv_ = heads(rq), heads(rk) * (HEAD_DIM ** -0.5), heads(rv)
    log_gamma = jax.nn.log_sigmoid(lp['ret_decay'].astype(jnp.float32))
    o_f, s_f = retention_scan(rq_, rk_, rv_, log_gamma[0], ret_init[:, 0])
    o_b, s_b = retention_scan(rq_[:, :, ::-1], rk_[:, :, ::-1], rv_[:, :, ::-1], log_gamma[1], ret_init[:, 1])
    ret = head_norm(o_f + o_b[:, :, ::-1]).transpose(0, 2, 1, 3).reshape(B, L, RET_WIDTH)
    ret = jax.nn.silu(rg) * ret

    hy = centred_dwconv3(hy, lp['hy_conv'])
    parts = jnp.split(hy, HYENA_ORDER + 1, axis=-1)
    z = parts[0]
    filt = hyena_filters(L, lp['hf_w1'], lp['hf_b1'], lp['hf_freq'], lp['hf_w2'], lp['hf_b2'], lp['hf_w3'])
    for o in range(HYENA_ORDER):
        z = parts[o + 1] * (centred_long_conv(z, filt[:, o, 0], filt[:, o, 1]) + z * lp['hy_bias'][o])

    out = jnp.concatenate([att, ret, z], -1) @ lp['w_out']
    return out, (own_k, own_v, jnp.stack([s_f, s_b], axis=1))


def conv_ffn(h, lp):
    up = centred_dwconv3(h @ lp['w_up'], lp['ffn_conv'])
    g, u = jnp.split(up, 2, axis=-1)
    return (jax.nn.silu(g) * u) @ lp['w_down']


def trunk_layer(x, mod, lp, rope, ctx_k, ctx_v, ret_init):
    sh1, sc1, g1, sh2, sc2, g2 = jnp.split(mod, 6, axis=-1)
    mix, ctx_state = mixing(x * (1 + sc1) + sh1, lp, rope, ctx_k, ctx_v, ret_init)
    x = layer_norm(DEEPNORM_ALPHA * x + g1 * mix, lp['ln1_w'], lp['ln1_b'])
    ffn = conv_ffn(x * (1 + sc2) + sh2, lp)
    x = layer_norm(DEEPNORM_ALPHA * x + g2 * ffn, lp['ln2_w'], lp['ln2_b'])
    return x, ctx_state


def setup_inputs(seed: int = 0) -> dict:
    key = jax.random.key(seed)
    ks = iter(jax.random.split(key, 40))

    def nrm(shape, std):
        return std * jax.random.normal(next(ks), shape, jnp.float32)

    D = D_MODEL
    x_prompt = nrm((BATCH, SEQ, D), 1.0)
    x_sample = nrm((DEC_BATCH, DEC_SEQ, D), 1.0)
    cache_k = nrm((DEC_BATCH, DEPTH, N_KV_HEADS, PAST_LEN, HEAD_DIM), 1.0)
    cache_v = nrm((DEC_BATCH, DEPTH, N_KV_HEADS, PAST_LEN, HEAD_DIM), 1.0)
    state_ret = nrm((DEC_BATCH, DEPTH, 2, N_RET_HEADS, HEAD_DIM, HEAD_DIM), 1.0)
    c = nrm((DEC_BATCH, D), 1.0)
    c_ctx = nrm((D,), 1.0)
    w_ada = nrm((DEPTH, D, 6 * D), 0.5 * D ** -0.5)
    b_ada = nrm((DEPTH, 6 * D), 0.01)
    w_in = nrm((DEPTH, D, IN_WIDTH), D ** -0.5)
    q_norm = 1.0 + nrm((DEPTH, HEAD_DIM), 0.02)
    k_norm = 1.0 + nrm((DEPTH, HEAD_DIM), 0.02)
    ret_base = jnp.log(2.0 ** (5.0 + jnp.arange(N_RET_HEADS, dtype=jnp.float32)) - 1.0)
    ret_decay = ret_base[None, None, :] + nrm((DEPTH, 2, N_RET_HEADS), 0.1)
    hy_conv = nrm((DEPTH, 3, (HYENA_ORDER + 1) * HYENA_WIDTH), 0.5)
    hf_w1 = nrm((DEPTH, FILTER_EMB, FILTER_HID), FILTER_EMB ** -0.5)
    hf_b1 = nrm((DEPTH, FILTER_HID), 0.1)
    hf_freq = 1.0 + nrm((DEPTH, FILTER_HID), 0.02)
    hf_w2 = nrm((DEPTH, FILTER_HID, FILTER_HID), FILTER_HID ** -0.5)
    hf_b2 = nrm((DEPTH, FILTER_HID), 0.1)
    hf_w3 = nrm((DEPTH, FILTER_HID, HYENA_ORDER * 2 * HYENA_WIDTH), 0.1 * FILTER_HID ** -0.5)
    hy_bias = nrm((DEPTH, HYENA_ORDER, HYENA_WIDTH), 0.5)
    w_out = nrm((DEPTH, MIX_WIDTH, D), DEEPNORM_BETA * MIX_WIDTH ** -0.5)
    ln1_w = 1.0 + nrm((DEPTH, D), 0.02)
    ln1_b = nrm((DEPTH, D), 0.01)
    w_up = nrm((DEPTH, D, 2 * D_FF), D ** -0.5)
    ffn_conv = nrm((DEPTH, 3, 2 * D_FF), 0.5)
    w_down = nrm((DEPTH, D_FF, D), DEEPNORM_BETA * D_FF ** -0.5)
    ln2_w = 1.0 + nrm((DEPTH, D), 0.02)
    ln2_b = nrm((DEPTH, D), 0.01)
    return {'x_prompt': x_prompt, 'x_sample': x_sample, 'cache_k': cache_k, 'cache_v': cache_v,
            'state_ret': state_ret, 'c': c, 'c_ctx': c_ctx, 'w_ada': w_ada, 'b_ada': b_ada,
            'w_in': w_in, 'q_norm': q_norm, 'k_norm': k_norm, 'ret_decay': ret_decay,
            'hy_conv': hy_conv, 'hf_w1': hf_w1, 'hf_b1': hf_b1, 'hf_freq': hf_freq, 'hf_w2': hf_w2,
            'hf_b2': hf_b2, 'hf_w3': hf_w3, 'hy_bias': hy_bias, 'w_out': w_out, 'ln1_w': ln1_w,
            'ln1_b': ln1_b, 'w_up': w_up, 'ffn_conv': ffn_conv, 'w_down': w_down,
            'ln2_w': ln2_w, 'ln2_b': ln2_b}


def reference(x_prompt, x_sample, cache_k, cache_v, state_ret, c, c_ctx, w_ada, b_ada, w_in,
              q_norm, k_norm, ret_decay, hy_conv, hf_w1, hf_b1, hf_freq, hf_w2, hf_b2, hf_w3,
              hy_bias, w_out, ln1_w, ln1_b, w_up, ffn_conv, w_down, ln2_w, ln2_b):
    rope = axial_rope_tables(x_sample.shape[1])
    ret_zero = jnp.zeros((x_prompt.shape[0], 2, N_RET_HEADS, HEAD_DIM, HEAD_DIM), x_prompt.dtype)
    y_p, y_s = x_prompt, x_sample
    ks_out, vs_out, ss_out = [], [], []
    for l in range(DEPTH):
        lp = {'w_in': w_in[l], 'q_norm': q_norm[l], 'k_norm': k_norm[l], 'ret_decay': ret_decay[l],
              'hy_conv': hy_conv[l], 'hf_w1': hf_w1[l], 'hf_b1': hf_b1[l], 'hf_freq': hf_freq[l],
              'hf_w2': hf_w2[l], 'hf_b2': hf_b2[l], 'hf_w3': hf_w3[l], 'hy_bias': hy_bias[l],
              'w_out': w_out[l], 'ln1_w': ln1_w[l], 'ln1_b': ln1_b[l], 'w_up': w_up[l],
              'ffn_conv': ffn_conv[l], 'w_down': w_down[l], 'ln2_w': ln2_w[l], 'ln2_b': ln2_b[l]}
        mod_ctx = (jax.nn.silu(c_ctx) @ w_ada[l] + b_ada[l])[None, None, :]
        mod_lat = (jax.nn.silu(c) @ w_ada[l] + b_ada[l])[:, None, :]
        y_p, (k_l, v_l, s_l) = trunk_layer(y_p, mod_ctx, lp, None, None, None, ret_zero)
        ks_out.append(k_l)
        vs_out.append(v_l)
        ss_out.append(s_l)
        y_s, _ = trunk_layer(y_s, mod_lat, lp, rope, cache_k[:, l], cache_v[:, l], state_ret[:, l])
    new_cache_k = jnp.stack(ks_out, axis=1)
    new_cache_v = jnp.stack(vs_out, axis=1)
    new_state_ret = jnp.stack(ss_out, axis=1)
    return (y_p, y_s, new_cache_k, new_cache_v, new_state_ret)
```

```cpp
#include <hip/hip_runtime.h>
#include <hip/hip_cooperative_groups.h>
#include <cstdio>
#include <cstdint>
namespace cg = cooperative_groups;
__device__ __forceinline__ int opaque_tid() { int t = threadIdx.x; asm volatile("" : "+v"(t)); return t; }
namespace pg8 {
#define PG8_LAS __attribute__((address_space(3)))
typedef unsigned short bf16_t;
typedef short bf16x8 __attribute__((ext_vector_type(8)));
typedef float f32x4 __attribute__((ext_vector_type(4)));
typedef unsigned u32x4 __attribute__((ext_vector_type(4)));
constexpr int BM = 256, BK = 64, HALF = 128, HTB = HALF * BK * 2  , STAGE_BYTES = 8 * HTB, NXCD = 8, WGM = 8;

__host__ __device__ __forceinline__ int lds_byte(int r, int c) { const int st = (r >> 4) * 2 + (c >> 5), rr = r & 15, cc = c & 31, ob = rr * 64 + cc * 2; return st * 1024 + (ob ^ (((ob >> 9) & 1) << 5)); }
__host__ __device__ __forceinline__ void stage_rc(int b, int& R, int& C) { const int st = b / 1024, sb = b % 1024, swz = sb ^ (((sb >> 9) & 1) << 5); R = (st >> 1) * 16 + swz / 64; C = (st & 1) * 32 + (swz % 64) / 2; }
__host__ __device__ __forceinline__ int perm32(int rho) { const int n = rho >> 4, i = rho & 15; return 8 * (i >> 2) + 4 * n + (i & 3); }

struct Unit { int pm, pn; };
struct Gemm { const bf16_t* A; const bf16_t* Bt; int M, N, K; };

struct StaticOrder {
    int nM, nN, nwg, G, c;
    __host__ __device__ void init(int M, int N, int G_, int c_) { nM = M / BM; nN = N / BM; nwg = nM * nN; G = G_; c = c_; }
    __host__ __device__ bool next(int i, Unit& u) const {
        const long L = (long)i * G + c; if (L >= nwg) return false;
        int wgid = (int)L; { const int q = nwg / NXCD, r = nwg % NXCD, xcd = wgid % NXCD, off = wgid / NXCD; wgid = (xcd < r ? xcd * (q + 1) : r * (q + 1) + (xcd - r) * q) + off; }
        const int nig = WGM * nN, gid = wgid / nig, fm = gid * WGM, gsz = (nM - fm) < WGM ? (nM - fm) : WGM;
        u.pm = fm + ((wgid % nig) % gsz); u.pn = (wgid % nig) / gsz; return true;
    }
    __device__ __forceinline__ void a_ready(const Unit&) const {}
    __device__ __forceinline__ void done(const Unit&) const {}
};
__device__ __forceinline__ unsigned cvt_pk_bf16(float lo, float hi) { unsigned r; asm volatile("v_cvt_pk_bf16_f32 %0, %1, %2" : "=v"(r) : "v"(lo), "v"(hi)); return r; }
struct EpiBf16 {
    static constexpr bool PERM = true, AFTER_DRAIN = false;
    bf16_t* O; int ldc;
    __device__ __forceinline__ void operator()(const f32x4 (&acc)[2][2][4][2], const Unit& u, int wr, int wc, int fr, int fq) const {
        const int row0 = u.pm * BM + wr * 64 + fr, col0 = u.pn * BM + wc * 32 + 8 * fq;
#pragma unroll
        for (int ai = 0; ai < 2; ++ai)
#pragma unroll
            for (int m = 0; m < 4; ++m) { bf16_t* rowp = O + (size_t)(row0 + ai * HALF + m * 16) * ldc + col0;
#pragma unroll
                for (int bj = 0; bj < 2; ++bj) { const f32x4 v0 = acc[ai][bj][m][0], v1 = acc[ai][bj][m][1];
                    u32x4 w; w.x = cvt_pk_bf16(v0[0], v0[1]); w.y = cvt_pk_bf16(v0[2], v0[3]); w.z = cvt_pk_bf16(v1[0], v1[1]); w.w = cvt_pk_bf16(v1[2], v1[3]);
                    *(u32x4*)(rowp + bj * HALF) = w; } }
    }
};
struct EpiResid {
    static constexpr bool PERM = false, AFTER_DRAIN = false;
    const float* xp; const float* xs; float* Y; const float* gate; float alpha;
    __device__ __forceinline__ void operator()(const f32x4 (&acc)[2][2][4][2], const Unit& u, int wr, int wc, int fr, int fq) const {
        const int modrow = u.pm < 16 ? 0 : 1 + ((u.pm - 16) >> 2);
        const float* g = gate + (size_t)modrow * 12288;
        const int row0 = u.pm * BM + wr * 64 + fr, col0 = u.pn * BM + wc * 32 + 4 * fq;
        f32x4 gv[2][2];
#pragma unroll
        for (int bj = 0; bj < 2; ++bj)
#pragma unroll
            for (int n = 0; n < 2; ++n) gv[bj][n] = *(const f32x4*)(g + col0 + bj * HALF + n * 16);
#pragma unroll
        for (int ai = 0; ai < 2; ++ai)
#pragma unroll
            for (int m = 0; m < 4; ++m) { const int r = row0 + ai * HALF + m * 16;
                const float* xrow = (r < 4096 ? xp + (size_t)r * 2048 : xs + (size_t)(r - 4096) * 2048) + col0; float* yrow = Y + (size_t)r * 2048 + col0;
#pragma unroll
                for (int bj = 0; bj < 2; ++bj)
#pragma unroll
                    for (int n = 0; n < 2; ++n) { const f32x4 xv = *(const f32x4*)(xrow + bj * HALF + n * 16);
                        *(f32x4*)(yrow + bj * HALF + n * 16) = xv * alpha + gv[bj][n] * acc[ai][bj][m][n]; }
                asm volatile("" ::: "memory"); }
    }
};
template <class Epi, class Sched, bool STAMP = false>
__device__ __forceinline__ void gemm_phase(PG8_LAS unsigned char* lds, const Gemm g, const Sched& S, const Epi& E, unsigned long long* stamps) {
    const int tid = ::opaque_tid(), wid = __builtin_amdgcn_readfirstlane(tid >> 6), lane = tid & 63, wr = wid >> 2, wc = wid & 3, fr = lane & 15, fq = lane >> 4;
    const int K = g.K, nt = K / BK;
    int ts_lo = 0, ts_hi = 0, nts = 0; const unsigned long long rt_entry = STAMP ? (unsigned long long)wall_clock64() : 0ull;
#define PG8_STAMP() do { if (STAMP && wid == 0 && nts < 64) { const unsigned long long _c = (unsigned long long)clock64(); \
        ts_lo = (lane == nts) ? (int)(unsigned)_c : ts_lo; ts_hi = (lane == nts) ? (int)(unsigned)(_c >> 32) : ts_hi; ++nts; } } while (0)
    PG8_STAMP();
    unsigned voffA[2], voffB[2];
#pragma unroll
    for (int i = 0; i < 2; ++i) { int R, C; stage_rc(tid * 16 + i * 8192, R, C); const int Rb = Epi::PERM ? ((R & ~31) + perm32(R & 31)) : R;
        voffA[i] = (unsigned)(R * K + C) * 2u; voffB[i] = (unsigned)(Rb * K + C) * 2u; }
    const size_t kstep = (size_t)(BK * 2);
    const size_t hstep = (size_t)HALF * K * 2;
    const size_t tstep = 2 * hstep;
    const unsigned ldsw = (unsigned)wid * 1024u;
    const int aoff = lds_byte(wr * 64 + fr, fq * 8), boff = lds_byte(wc * 32 + fr, fq * 8);
#define PG8_SA(b, h) (((b) * 2 + (h)) * HTB)
#define PG8_SB(b, h) ((4 + (b) * 2 + (h)) * HTB)
#define PG8_STAGE(bufoff, gbase, voff) do { _Pragma("unroll") for (int _i = 0; _i < 2; ++_i) \
        __builtin_amdgcn_global_load_lds((const unsigned*)((const char*)(gbase) + (voff)[_i]), (PG8_LAS unsigned*)(lds + (bufoff) + ldsw + _i * 8192), 16, 0, 0); } while (0)
#define PG8_LDA(dst, b, h) do { _Pragma("unroll") for (int m = 0; m < 4; ++m) _Pragma("unroll") for (int k = 0; k < 2; ++k) dst[m][k] = *(const PG8_LAS bf16x8*)(lds + PG8_SA(b, h) + aoff + m * 2048 + k * 1024); } while (0)
#define PG8_LDB(dst, b, h) do { _Pragma("unroll") for (int n = 0; n < 2; ++n) _Pragma("unroll") for (int k = 0; k < 2; ++k) dst[n][k] = *(const PG8_LAS bf16x8*)(lds + PG8_SB(b, h) + boff + n * 2048 + k * 1024); } while (0)
#define PG8_MMA(ai, bj, At, Bt) do { __builtin_amdgcn_s_setprio(1); _Pragma("unroll") for (int m = 0; m < 4; ++m) _Pragma("unroll") for (int n = 0; n < 2; ++n) _Pragma("unroll") for (int k = 0; k < 2; ++k) \
        acc[ai][bj][m][n] = __builtin_amdgcn_mfma_f32_16x16x32_bf16(Bt[n][k], At[m][k], acc[ai][bj][m][n], 0, 0, 0); __builtin_amdgcn_s_setprio(0); } while (0)
#define PG8_WAIT_V(n) asm volatile("s_waitcnt vmcnt(" #n ")" ::: "memory")
#define PG8_WAIT_L(n) asm volatile("s_waitcnt lgkmcnt(" #n ")" ::: "memory")
#define PG8_BAR __builtin_amdgcn_s_barrier()
#define PG8_SCHED __builtin_amdgcn_sched_barrier(0)
    Unit cur, nxt; int ui = 0;
    if (!S.next(0, cur)) return;
    f32x4 acc[2][2][4][2];
#pragma unroll
    for (int a = 0; a < 2; ++a)
#pragma unroll
        for (int b = 0; b < 2; ++b)
#pragma unroll
            for (int m = 0; m < 4; ++m)
#pragma unroll
                for (int n = 0; n < 2; ++n) acc[a][b][m][n] = (f32x4){0.f, 0.f, 0.f, 0.f};
    bf16x8 At[4][2], B0[2][2], B1[2][2];
    const char* cA = (const char*)g.A + (size_t)cur.pm * tstep; const char* cB = (const char*)g.Bt + (size_t)cur.pn * tstep;
    S.a_ready(cur);
    PG8_STAGE(PG8_SB(0, 0), cB, voffB); PG8_STAGE(PG8_SA(0, 0), cA, voffA); PG8_STAGE(PG8_SB(0, 1), cB + hstep, voffB); PG8_STAGE(PG8_SA(0, 1), cA + hstep, voffA);
    if (wr == 1) PG8_BAR;
    PG8_WAIT_V(4); PG8_BAR;
    PG8_STAGE(PG8_SB(1, 0), cB + kstep, voffB); PG8_STAGE(PG8_SA(1, 0), cA + kstep, voffA); PG8_STAGE(PG8_SB(1, 1), cB + hstep + kstep, voffB);
    PG8_WAIT_V(6); PG8_BAR;
    PG8_STAMP();
    for (;;) {
        const bool has_next = S.next(ui + 1, nxt);
        const char* nA = has_next ? (const char*)g.A + (size_t)nxt.pm * tstep : cA; const char* nB = has_next ? (const char*)g.Bt + (size_t)nxt.pn * tstep : cB;
        for (int t = 0; t < nt; t += 2) {
            const bool last = (t == nt - 2);
            const char* a1 = cA + (size_t)(t + 1) * kstep;
            const char* a2 = last ? nA : cA + (size_t)(t + 2) * kstep; const char* b2 = last ? nB : cB + (size_t)(t + 2) * kstep;
            const char* a3 = a2 + kstep; const char* b3 = b2 + kstep;
            if (last && has_next) S.a_ready(nxt);
            PG8_LDB(B0, 0, 0); PG8_SCHED; PG8_LDA(At, 0, 0); PG8_STAGE(PG8_SA(1, 1), a1 + hstep, voffA);
            PG8_WAIT_L(8); PG8_BAR; PG8_WAIT_L(0); PG8_MMA(0, 0, At, B0); PG8_BAR; PG8_SCHED;
            PG8_LDB(B1, 0, 1); PG8_STAGE(PG8_SB(0, 0), b2, voffB);
            PG8_BAR; PG8_WAIT_L(0); PG8_MMA(0, 1, At, B1); PG8_BAR;
            PG8_LDA(At, 0, 1); PG8_STAGE(PG8_SA(0, 0), a2, voffA);
            PG8_BAR; PG8_WAIT_L(0); PG8_MMA(1, 0, At, B0); PG8_BAR; PG8_SCHED;
            PG8_STAGE(PG8_SB(0, 1), b2 + hstep, voffB);
            PG8_WAIT_V(6); PG8_BAR; PG8_MMA(1, 1, At, B1); PG8_BAR;
            PG8_LDB(B0, 1, 0); PG8_SCHED; PG8_LDA(At, 1, 0); PG8_STAGE(PG8_SA(0, 1), a2 + hstep, voffA);
            PG8_WAIT_L(8); PG8_BAR; PG8_WAIT_L(0); PG8_MMA(0, 0, At, B0); PG8_BAR; PG8_SCHED;
            PG8_LDB(B1, 1, 1); PG8_STAGE(PG8_SB(1, 0), b3, voffB);
            PG8_BAR; PG8_WAIT_L(0); PG8_MMA(0, 1, At, B1); PG8_BAR;
            PG8_LDA(At, 1, 1); PG8_STAGE(PG8_SA(1, 0), a3, voffA);
            PG8_BAR; PG8_WAIT_L(0); PG8_MMA(1, 0, At, B0); PG8_BAR; PG8_SCHED;
            PG8_STAGE(PG8_SB(1, 1), b3 + hstep, voffB);
            PG8_WAIT_V(6); PG8_BAR; PG8_MMA(1, 1, At, B1); PG8_BAR;
        }
        PG8_STAMP();
        if constexpr (!Epi::AFTER_DRAIN) { E(acc, cur, wr, wc, fr, fq); S.done(cur); }
        PG8_STAMP();
        if (!has_next) break;
#pragma unroll
        for (int a = 0; a < 2; ++a)
#pragma unroll
            for (int b = 0; b < 2; ++b)
#pragma unroll
                for (int m = 0; m < 4; ++m)
#pragma unroll
                    for (int n = 0; n < 2; ++n) acc[a][b][m][n] = (f32x4){0.f, 0.f, 0.f, 0.f};
        cur = nxt; cA = nA; cB = nB; ++ui;
    }
    PG8_WAIT_V(0);
    if (wr == 0) PG8_BAR;
    PG8_BAR;
    if constexpr (Epi::AFTER_DRAIN) { E.fused(acc, cur, wr, wc, fr, fq, lds, wid, lane); S.done(cur); }
    PG8_STAMP();
    if (STAMP && wid == 0) { stamps[lane] = lane < nts ? (((unsigned long long)(unsigned)ts_hi << 32) | (unsigned)ts_lo) : 0ull;
        if (lane == 62) stamps[62] = rt_entry; if (lane == 63) stamps[63] = (unsigned long long)wall_clock64(); }
#undef PG8_STAMP
#undef PG8_SA
#undef PG8_SB
#undef PG8_STAGE
#undef PG8_LDA
#undef PG8_LDB
#undef PG8_MMA
#undef PG8_WAIT_V
#undef PG8_WAIT_L
#undef PG8_BAR
#undef PG8_SCHED
}
}
namespace att {
using bf16 = unsigned short;
constexpr int   D = 128, NW = 8, QBLK = 32, KVBLK = 64;
constexpr float SCALE = 0.088388347648318440f;
constexpr float THR = 8.f;
constexpr int SDEPTH = 2;
constexpr size_t SHM_V = KVBLK * D * 2, SHM_K = KVBLK * D * 2, SHM_ATTN = 2 * SHM_V + 2 * SHM_K + NW * 64 * 4;
using bf16x8 = __attribute__((ext_vector_type(8))) short;
using s16x4  = __attribute__((ext_vector_type(4))) short;
using f32x16 = __attribute__((ext_vector_type(16))) float;
using f32x8  = __attribute__((ext_vector_type(8))) float;
using u32x4  = __attribute__((ext_vector_type(4))) unsigned;
#define KSWZ(row, colB) ((row) * 256 + ((colB) ^ (((row) & 7) << 4)))
#define SBAR() __builtin_amdgcn_sched_barrier(0)
__device__ __forceinline__ int crow(int r, int hi) { return (r & 3) + 8 * (r >> 2) + 4 * hi; }
__device__ __forceinline__ unsigned cvtpk(float lo, float hi) {
  unsigned r; asm volatile("v_cvt_pk_bf16_f32 %0, %1, %2" : "=v"(r) : "v"(lo), "v"(hi)); return r;
}
struct St { using T = bf16x8;
  __device__ static __forceinline__ T ld8(const bf16* p) { return *reinterpret_cast<const bf16x8*>(p); }
  __device__ static __forceinline__ bf16x8 tobf(T x) { return x; } };
__device__ __forceinline__ void partialSM(f32x16& p0, f32x16& p1, float& m_reg, float& mn, float& alpha) {
  constexpr float C = SCALE * 1.4426950408889634f;
  float pmax = p0[0]; for (int r = 1; r < 16; ++r) pmax = fmaxf(pmax, p0[r]); for (int r = 0; r < 16; ++r) pmax = fmaxf(pmax, p1[r]);
  { auto rr = __builtin_amdgcn_permlane32_swap(__float_as_uint(pmax), __float_as_uint(pmax), false, false);
    pmax = fmaxf(__uint_as_float(rr[0]), __uint_as_float(rr[1])); }
  if (__builtin_expect(__all(pmax - m_reg <= THR / SCALE), 1)) { mn = m_reg; alpha = 1.f; }
  else { mn = fmaxf(m_reg, pmax); alpha = __builtin_amdgcn_exp2f((m_reg - mn) * C); m_reg = mn; }
  float mnC = -mn * C;
  for (int r = 0; r < 16; ++r) p0[r] = fmaf(p0[r], C, mnC); for (int r = 0; r < 16; ++r) p1[r] = fmaf(p1[r], C, mnC);
  for (int r = 0; r < 16; ++r) p0[r] = __builtin_amdgcn_exp2f(p0[r]);
}
__device__ __forceinline__ void finishSM(f32x16& p0, f32x16& p1, float alpha, float& l_reg, bf16x8& pa0, bf16x8& pa1, bf16x8& pa2, bf16x8& pa3) {
  for (int r = 0; r < 16; ++r) p1[r] = __builtin_amdgcn_exp2f(p1[r]);
  float ps = 0; for (int r = 0; r < 16; ++r) ps += p0[r]; for (int r = 0; r < 16; ++r) ps += p1[r];
  { auto rr = __builtin_amdgcn_permlane32_swap(__float_as_uint(ps), __float_as_uint(ps), false, false);
    ps = __uint_as_float(rr[0]) + __uint_as_float(rr[1]); }
  l_reg = l_reg * alpha + ps;
#define PK4(P, BASE, OUT) do { unsigned a0 = cvtpk(P[BASE + 0], P[BASE + 1]), a1 = cvtpk(P[BASE + 2], P[BASE + 3]);   \
    unsigned b0 = cvtpk(P[BASE + 4], P[BASE + 5]), b1 = cvtpk(P[BASE + 6], P[BASE + 7]);                              \
    auto r0 = __builtin_amdgcn_permlane32_swap(a0, b0, false, false); auto r1 = __builtin_amdgcn_permlane32_swap(a1, b1, false, false); \
    u32x4 w = {r0[0], r1[0], r0[1], r1[1]}; OUT = *reinterpret_cast<bf16x8*>(&w); } while (0)
  PK4(p0, 0, pa0); PK4(p0, 8, pa1); PK4(p1, 0, pa2); PK4(p1, 8, pa3);
#undef PK4
}
__device__ __forceinline__ void qkt(f32x16& p0, f32x16& p1, const bf16* Ks, const bf16x8* qr, int r32, int hi) {
  p0 = f32x16{}; p1 = f32x16{};
  for (int d0 = 0; d0 < 8; ++d0) { int cb = (d0 * 16 + hi * 8) * 2;
    bf16x8 b0 = *reinterpret_cast<const bf16x8*>((const char*)Ks + KSWZ(r32, cb));
    bf16x8 b1 = *reinterpret_cast<const bf16x8*>((const char*)Ks + KSWZ(32 + r32, cb));
    p0 = __builtin_amdgcn_mfma_f32_32x32x16_bf16(b0, qr[d0], p0, 0, 0, 0);
    p1 = __builtin_amdgcn_mfma_f32_32x32x16_bf16(b1, qr[d0], p1, 0, 0, 0); }
}
__device__ __forceinline__ int v_st(int k, int c) { const int kk = (k & ~0xC) | ((k & 4) << 1) | ((k & 8) >> 1); return ((kk >> 3) * 4 + (c >> 5)) * 512 + ((kk & 7) * 32 + (c & 31)) * 2; }
__device__ __forceinline__ int v_rd_base(int lane) { return ((lane & 3) << 3) | (((lane >> 2) & 3) << 6) | (((lane >> 4) & 1) << 5) | (((lane >> 5) & 1) << 8); }
constexpr int v_rd_off(int d0, int ks, int half) { return d0 * 512 + ks * 4096 + half * 2048; }
template <int OFF> __device__ __forceinline__ s16x4 tr_read(int vb) {
  s16x4 r; asm volatile("ds_read_b64_tr_b16 %0, %1 offset:%2" : "=&v"(r) : "v"(vb), "i"(OFF) : "memory"); return r;
}
template <int D0> __device__ __forceinline__ void pv_one(f32x16& od, int vb, bf16x8 pa0, bf16x8 pa1, bf16x8 pa2, bf16x8 pa3) {
  const s16x4 l0 = tr_read<v_rd_off(D0, 0, 0)>(vb), h0 = tr_read<v_rd_off(D0, 0, 1)>(vb), l1 = tr_read<v_rd_off(D0, 1, 0)>(vb), h1 = tr_read<v_rd_off(D0, 1, 1)>(vb);
  const s16x4 l2 = tr_read<v_rd_off(D0, 2, 0)>(vb), h2 = tr_read<v_rd_off(D0, 2, 1)>(vb), l3 = tr_read<v_rd_off(D0, 3, 0)>(vb), h3 = tr_read<v_rd_off(D0, 3, 1)>(vb);
  asm volatile("s_waitcnt lgkmcnt(0)" ::: "memory"); SBAR();
#define PK(L, H) (bf16x8){L[0], L[1], L[2], L[3], H[0], H[1], H[2], H[3]}
  od = __builtin_amdgcn_mfma_f32_32x32x16_bf16(pa0, PK(l0, h0), od, 0, 0, 0);
  od = __builtin_amdgcn_mfma_f32_32x32x16_bf16(pa1, PK(l1, h1), od, 0, 0, 0);
  od = __builtin_amdgcn_mfma_f32_32x32x16_bf16(pa2, PK(l2, h2), od, 0, 0, 0);
  od = __builtin_amdgcn_mfma_f32_32x32x16_bf16(pa3, PK(l3, h3), od, 0, 0, 0);
#undef PK
}
__device__ __forceinline__ void pv_d0(f32x16* o, int vb, bf16x8 pa0, bf16x8 pa1, bf16x8 pa2, bf16x8 pa3) {
  pv_one<0>(o[0], vb, pa0, pa1, pa2, pa3); pv_one<1>(o[1], vb, pa0, pa1, pa2, pa3); pv_one<2>(o[2], vb, pa0, pa1, pa2, pa3); pv_one<3>(o[3], vb, pa0, pa1, pa2, pa3);
}
template <int LDQ, int LDK, int LDO>
__device__ __forceinline__ void attn_dense_body(const bf16* __restrict__ Qb, const bf16* __restrict__ Kh, const bf16* __restrict__ Vh,
                                                bf16* __restrict__ Ob, int seq, char* lds) {
  const int tid = ::opaque_tid(), wid = tid >> 6, lane = tid & 63, r32 = lane & 31, hi = lane >> 5;
  bf16* V_lds = (bf16*)lds; bf16* K_lds = (bf16*)(lds + 2 * SHM_V);
  float* ws = (float*)(lds + 2 * SHM_V + 2 * SHM_K) + wid * 64; float* li_l = ws; float* al_l = ws + 32;
  float m_reg = -1e30f, l_reg = 0; f32x16 o[4] = {}; bf16x8 qr[8];
  const bf16* Qw = Qb + (long)(wid * QBLK + r32) * LDQ + hi * 8;
#pragma unroll
  for (int d0 = 0; d0 < 8; ++d0) qr[d0] = St::ld8(Qw + d0 * 16);
  const int sr = tid >> 4, sc = (tid & 15) * 8, vst0 = v_st(sr, sc), vst1 = v_st(32 + sr, sc);
  const int vb0 = (int)(uintptr_t)V_lds + v_rd_base(lane);
  struct { typename St::T vs0, vs1, ks0, ks1; } sr_[SDEPTH];
#define SLOAD(i, k0) do { sr_[i].vs0 = St::ld8(&Vh[(long)((k0) + sr) * LDK + sc]); sr_[i].vs1 = St::ld8(&Vh[(long)((k0) + 32 + sr) * LDK + sc]); \
    sr_[i].ks0 = St::ld8(&Kh[(long)((k0) + sr) * LDK + sc]); sr_[i].ks1 = St::ld8(&Kh[(long)((k0) + 32 + sr) * LDK + sc]); } while (0)
#define SWRITE(b, i) do { *(bf16x8*)((char*)V_lds + (b) * SHM_V + vst0) = St::tobf(sr_[i].vs0);          \
    *(bf16x8*)((char*)V_lds + (b) * SHM_V + vst1) = St::tobf(sr_[i].vs1); int kc = sc * 2;               \
    *(bf16x8*)((char*)K_lds + (b) * SHM_K + KSWZ(sr, kc)) = St::tobf(sr_[i].ks0);                       \
    *(bf16x8*)((char*)K_lds + (b) * SHM_K + KSWZ(32 + sr, kc)) = St::tobf(sr_[i].ks1); } while (0)
#define SWAIT() do { asm volatile("s_waitcnt vmcnt(4)" ::: "memory"); } while (0)
#define RESC(a) do { if (__any((a) < 1.f)) { if (hi == 0) al_l[r32] = (a); asm volatile("s_waitcnt lgkmcnt(0)" ::: "memory"); \
    for (int d = 0; d < 4; ++d) for (int r = 0; r < 16; ++r) o[d][r] *= al_l[crow(r, hi)]; } } while (0)
  f32x16 pA0, pA1, pB0, pB1; float mnA, mnB, alA, alB; bf16x8 pa0, pa1, pa2, pa3; const int NT = seq / KVBLK;
  constexpr int SE = 0, SO = SDEPTH - 1;
  SLOAD(SE, 0); asm volatile("s_waitcnt vmcnt(0)" ::: "memory"); SWRITE(0, SE); __syncthreads();
  qkt(pA0, pA1, K_lds, qr, r32, hi); partialSM(pA0, pA1, m_reg, mnA, alA);
  SLOAD(SO, KVBLK); if (2 < NT) SLOAD(SE, 2 * KVBLK);
  SWAIT(); SWRITE(1, SO); __syncthreads();
  for (int j = 1; j + 1 < NT; j += 2) {
    SBAR(); qkt(pB0, pB1, (bf16*)((char*)K_lds + SHM_K), qr, r32, hi);
    finishSM(pA0, pA1, alA, l_reg, pa0, pa1, pa2, pa3); SBAR();
    SLOAD(SO, (j + SDEPTH) * KVBLK); SBAR();
    pv_d0(o, vb0, pa0, pa1, pa2, pa3); partialSM(pB0, pB1, m_reg, mnB, alB);
    __syncthreads(); SWAIT(); SWRITE(0, SE);
    RESC(alB); __syncthreads();
    SBAR(); qkt(pA0, pA1, K_lds, qr, r32, hi);
    finishSM(pB0, pB1, alB, l_reg, pa0, pa1, pa2, pa3); SBAR();
    if (j + 3 < NT) SLOAD(SE, (j + 1 + SDEPTH) * KVBLK); SBAR();
    pv_d0(o, vb0 + (int)SHM_V, pa0, pa1, pa2, pa3); partialSM(pA0, pA1, m_reg, mnA, alA);
    __syncthreads(); SWAIT(); SWRITE(1, SO);
    RESC(alA); __syncthreads();
  }
  SBAR(); qkt(pB0, pB1, (bf16*)((char*)K_lds + SHM_K), qr, r32, hi);
  finishSM(pA0, pA1, alA, l_reg, pa0, pa1, pa2, pa3); SBAR();
  pv_d0(o, vb0, pa0, pa1, pa2, pa3); partialSM(pB0, pB1, m_reg, mnB, alB);
  __syncthreads(); RESC(alB);
  finishSM(pB0, pB1, alB, l_reg, pa0, pa1, pa2, pa3); SBAR();
  pv_d0(o, vb0 + (int)SHM_V, pa0, pa1, pa2, pa3);
  if (hi == 0) li_l[r32] = l_reg; asm volatile("s_waitcnt lgkmcnt(0)" ::: "memory");
  float rli[16];
#pragma unroll
  for (int r = 0; r < 16; ++r) rli[r] = __builtin_amdgcn_rcpf(li_l[crow(r, hi)]);
  bf16* Ow = Ob + (long)(wid * QBLK) * LDO;
#pragma unroll
  for (int r = 0; r < 16; ++r) { int orow = crow(r, hi);
#pragma unroll
    for (int d0 = 0; d0 < 4; ++d0) Ow[(long)orow * LDO + d0 * 32 + r32] = (bf16)(cvtpk(o[d0][r] * rli[r], 0.f) & 0xffffu); }
  __syncthreads();
}

__device__ __forceinline__ void packP(const f32x16& p0, const f32x16& p1, bf16x8& pa0, bf16x8& pa1, bf16x8& pa2, bf16x8& pa3) {
#define PK4(P, BASE, OUT) do { unsigned a0 = cvtpk(P[BASE + 0], P[BASE + 1]), a1 = cvtpk(P[BASE + 2], P[BASE + 3]);   \
    unsigned b0 = cvtpk(P[BASE + 4], P[BASE + 5]), b1 = cvtpk(P[BASE + 6], P[BASE + 7]);                              \
    auto r0 = __builtin_amdgcn_permlane32_swap(a0, b0, false, false); auto r1 = __builtin_amdgcn_permlane32_swap(a1, b1, false, false); \
    u32x4 w = {r0[0], r1[0], r0[1], r1[1]}; OUT = *reinterpret_cast<bf16x8*>(&w); } while (0)
  PK4(p0, 0, pa0); PK4(p0, 8, pa1); PK4(p1, 0, pa2); PK4(p1, 8, pa3);
#undef PK4
}
template <int MODE>
__device__ __forceinline__ void ret_weight(f32x16& p0, f32x16& p1, int jt, int nst, int n, int L, float lgf, float lgb, int hi) {
  if (MODE == 0 && jt < nst) {
    const float w = (jt < 2) ? __builtin_amdgcn_exp2f(lgf * (float)(n + 1)) : __builtin_amdgcn_exp2f(lgb * (float)(L - n));
#pragma unroll
    for (int r = 0; r < 16; ++r) { p0[r] *= w; p1[r] *= w; }
  } else {
    const int kb = (jt - (MODE == 0 ? nst : 0)) * 64;
#pragma unroll
    for (int r = 0; r < 16; ++r) {
#pragma unroll
      for (int half = 0; half < 2; ++half) {
        const int m = kb + crow(r, hi) + 32 * half; float w;
        if (MODE == 0) { const int diff = n - m; const float e = diff > 0 ? lgf * (float)diff : lgb * (float)(-diff);
          w = __builtin_amdgcn_exp2f(e) * SCALE; if (diff == 0) w = 2.f * SCALE; }
        else { const float e = (n >= 128) ? lgb * (float)m : lgf * (float)(L - 1 - m); w = __builtin_amdgcn_exp2f(e) * SCALE; }
        if (half == 0) p0[r] *= w; else p1[r] *= w;
      }
    }
  }
}
#define SWAIT0() do { asm volatile("s_waitcnt vmcnt(0)" ::: "memory"); } while (0)
template <int MODE, int LDQ>
__device__ __forceinline__ void retn_body(const bf16* __restrict__ Qb, const bf16* __restrict__ Kh, const bf16* __restrict__ Vh, int seq, int nst, int nq0, int L,
                                          float lgf, float lgb, const bf16* __restrict__ Gb, bf16* __restrict__ Ob, float* __restrict__ So, char* lds) {
  constexpr int LDK = 128;
  const int tid = ::opaque_tid(), wid = tid >> 6, lane = tid & 63, r32 = lane & 31, hi = lane >> 5;
  bf16* V_lds = (bf16*)lds; bf16* K_lds = (bf16*)(lds + 2 * SHM_V);
  f32x16 o[4] = {}; bf16x8 qr[8];
  const bf16* Qw = Qb + (long)(wid * QBLK + r32) * LDQ + hi * 8;
#pragma unroll
  for (int d0 = 0; d0 < 8; ++d0) qr[d0] = St::ld8(Qw + d0 * 16);
  const int nq = nq0 + wid * QBLK + r32;
  const int sr = tid >> 4, sc = (tid & 15) * 8, vst0 = v_st(sr, sc), vst1 = v_st(32 + sr, sc);
  const int vb0 = (int)(uintptr_t)V_lds + v_rd_base(lane);
  struct { typename St::T vs0, vs1, ks0, ks1; } sr_[1];
  f32x16 pA0, pA1, pB0, pB1; bf16x8 pa0, pa1, pa2, pa3; const int NT = seq / KVBLK;
  constexpr int SE = 0, SO = 0;
  SLOAD(SE, 0); asm volatile("s_waitcnt vmcnt(0)" ::: "memory"); SWRITE(0, SE); __syncthreads();
  qkt(pA0, pA1, K_lds, qr, r32, hi); ret_weight<MODE>(pA0, pA1, 0, nst, nq, L, lgf, lgb, hi);
  SLOAD(SO, KVBLK);
  SWAIT0(); SWRITE(1, SO); __syncthreads();
  for (int j = 1; j + 1 < NT; j += 2) {
    SBAR(); qkt(pB0, pB1, (bf16*)((char*)K_lds + SHM_K), qr, r32, hi);
    packP(pA0, pA1, pa0, pa1, pa2, pa3); SBAR();
    SLOAD(SO, (j + 1) * KVBLK); SBAR();
    pv_d0(o, vb0, pa0, pa1, pa2, pa3); ret_weight<MODE>(pB0, pB1, j, nst, nq, L, lgf, lgb, hi);
    __syncthreads(); SWAIT0(); SWRITE(0, SE);
    __syncthreads();
    SBAR(); qkt(pA0, pA1, K_lds, qr, r32, hi);
    packP(pB0, pB1, pa0, pa1, pa2, pa3); SBAR();
    SLOAD(SE, (j + 2) * KVBLK); SBAR();
    pv_d0(o, vb0 + (int)SHM_V, pa0, pa1, pa2, pa3); ret_weight<MODE>(pA0, pA1, j + 1, nst, nq, L, lgf, lgb, hi);
    __syncthreads(); SWAIT0(); SWRITE(1, SO);
    __syncthreads();
  }
  SBAR(); qkt(pB0, pB1, (bf16*)((char*)K_lds + SHM_K), qr, r32, hi);
  packP(pA0, pA1, pa0, pa1, pa2, pa3); SBAR();
  pv_d0(o, vb0, pa0, pa1, pa2, pa3); ret_weight<MODE>(pB0, pB1, NT - 1, nst, nq, L, lgf, lgb, hi);
  __syncthreads();
  packP(pB0, pB1, pa0, pa1, pa2, pa3); SBAR();
  pv_d0(o, vb0 + (int)SHM_V, pa0, pa1, pa2, pa3);
  if (MODE == 1) {
#pragma unroll
    for (int r = 0; r < 16; ++r) { const int n = wid * QBLK + crow(r, hi); float* rowp = So + (size_t)(n >> 7) * 65536 + (size_t)(n & 127) * 128;
#pragma unroll
      for (int d0 = 0; d0 < 4; ++d0) rowp[d0 * 32 + r32] = o[d0][r]; }
  } else {
#pragma unroll
    for (int r = 0; r < 16; ++r) { const int orow = wid * QBLK + crow(r, hi);
      float s = (o[0][r] + o[1][r]) + (o[2][r] + o[3][r]);
#pragma unroll
      for (int x = 1; x < 32; x <<= 1) s += __shfl_xor(s, x);
      const float mean = s * (1.f / 128.f);
      const float d0v = o[0][r] - mean, d1v = o[1][r] - mean, d2v = o[2][r] - mean, d3v = o[3][r] - mean;
      float q = (d0v * d0v + d1v * d1v) + (d2v * d2v + d3v * d3v);
#pragma unroll
      for (int x = 1; x < 32; x <<= 1) q += __shfl_xor(q, x);
      const float rstd = 1.0f / sqrtf(q * (1.f / 128.f) + 1e-6f);
      const float dv[4] = {d0v, d1v, d2v, d3v};
#pragma unroll
      for (int d0 = 0; d0 < 4; ++d0) { const float g = __uint_as_float(((unsigned)Gb[(long)orow * LDQ + d0 * 32 + r32]) << 16);
        const float sg = g / (1.f + __expf(-g));
        Ob[(long)orow * 2048 + d0 * 32 + r32] = (bf16)(cvtpk(sg * dv[d0] * rstd, 0.f) & 0xffffu); }
    }
  }
  __syncthreads();
}
#undef SLOAD
#undef SWRITE
#undef SWAIT
#undef SWAIT0
#undef RESC
}
#define LAS __attribute__((address_space(3)))
typedef unsigned short bf16_t;
typedef float f32x4 __attribute__((ext_vector_type(4)));
typedef float f32x2 __attribute__((ext_vector_type(2)));
typedef unsigned u32x4 __attribute__((ext_vector_type(4)));
typedef unsigned u32x2 __attribute__((ext_vector_type(2)));
typedef short bf16x8 __attribute__((ext_vector_type(8)));
constexpr int DM = 2048, MROWS = 12288, MCTX = 4096, NIN = 5120, DFF = 5632, NUP = 11264;
constexpr size_t MiB = (size_t)1 << 20;
constexpr size_t WS_CTL = 0, WS_MOD = 1 * MiB, WS_GF0 = 2 * MiB, WS_GF1 = 3 * MiB, WS_IDQ = 7 * MiB;
constexpr size_t WS_WIN = 10 * MiB, WS_WOUT = 30 * MiB, WS_WUP = 38 * MiB, WS_WDN = 82 * MiB, WS_H = 104 * MiB, WS_OV = 152 * MiB;
constexpr size_t WS_PROJ = WS_OV, WS_CONCAT = WS_OV + 120 * MiB, WS_QN = WS_OV + 168 * MiB, WS_KBL = WS_OV + 192 * MiB, WS_VBL = WS_OV + 198 * MiB,
                 WS_KBC = WS_OV + 204 * MiB, WS_VBC = WS_OV + 206 * MiB, WS_KEL = WS_OV + 208 * MiB, WS_VEL = WS_OV + 218 * MiB, WS_KEC = WS_OV + 228 * MiB,
                 WS_VEC = WS_OV + 232 * MiB, WS_HYT = WS_OV + 236 * MiB;
constexpr size_t WS_UP = WS_OV, WS_ACT = WS_OV + 264 * MiB, WS_END = WS_OV + 396 * MiB;
constexpr int LDS_BYTES = 147456, LDS_ITEM_OFF = LDS_BYTES - 64;
constexpr size_t OUT_CK = 25165824, OUT_CV = 27262976, OUT_ST = 29360128;

struct Params { const float* in[29]; float* out; unsigned char* ws; unsigned long long pad; };
typedef const __attribute__((address_space(4))) Params* KP;
__device__ __forceinline__ KP kp_fresh() { KP k = (KP)__builtin_amdgcn_kernarg_segment_ptr(); asm volatile("" : "+s"(k)); return k; }
enum { I_XP = 0, I_XS, I_CK, I_CV, I_ST, I_C, I_CCTX, I_WADA, I_BADA, I_WIN, I_QN, I_KN, I_RDEC, I_HYCONV, I_HW1, I_HB1, I_HFREQ, I_HW2, I_HB2, I_HW3, I_HYBIAS, I_WOUT,
       I_LN1W, I_LN1B, I_WUP, I_FFNCONV, I_WDN, I_LN2W, I_LN2B };

__device__ __forceinline__ unsigned f2bf(float f) { unsigned u = __builtin_bit_cast(unsigned, f); return (u + 0x7fffu + ((u >> 16) & 1u)) >> 16; }
__device__ __forceinline__ unsigned pk2(float lo, float hi) { return f2bf(lo) | (f2bf(hi) << 16); }
__device__ __forceinline__ float bf2f(unsigned short b) { return __uint_as_float(((unsigned)b) << 16); }
__device__ __forceinline__ float bflo(unsigned w) { return __uint_as_float(w << 16); }
__device__ __forceinline__ float bfhi(unsigned w) { return __uint_as_float(w & 0xffff0000u); }
__device__ __forceinline__ float wave_sum(float v) {
#pragma unroll
    for (int o = 1; o < 64; o <<= 1) v += __shfl_xor(v, o);
    return v;
}
__device__ __forceinline__ float silu_f(float x) { return x / (1.f + __expf(-x)); }

__device__ __forceinline__ void transpose_tile(const float* __restrict__ W, int K, int N, bf16_t* __restrict__ WT, LAS float* scr, int tile, int lane) {
    const int nblk = N >> 6, kb = tile / nblk, nb = tile - kb * nblk, k0 = kb * 64, n0 = nb * 64;
    float v[64];
    const float* src = W + (size_t)k0 * N + n0 + lane;
#pragma unroll
    for (int i = 0; i < 64; ++i) v[i] = src[(size_t)i * N];
#pragma unroll
    for (int i = 0; i < 64; ++i) scr[i * 65 + lane] = v[i];
    asm volatile("s_waitcnt lgkmcnt(0)" ::: "memory");
    const int c = lane & 7;
#pragma unroll
    for (int j = 0; j < 8; ++j) { const int n = (lane >> 3) + 8 * j; const LAS float* s = scr + (8 * c) * 65 + n;
        u32x4 o; o.x = pk2(s[0 * 65], s[1 * 65]); o.y = pk2(s[2 * 65], s[3 * 65]); o.z = pk2(s[4 * 65], s[5 * 65]); o.w = pk2(s[6 * 65], s[7 * 65]);
        *(u32x4*)(WT + (size_t)(n0 + n) * K + k0 + 8 * c) = o; }
    asm volatile("s_waitcnt lgkmcnt(0)" ::: "memory");
}
__device__ __forceinline__ void convert_weights(KP p, LAS unsigned char* lds, int l) {
    const int tid = opaque_tid(), wave = tid >> 6, lane = tid & 63;
    LAS float* scr = (LAS float*)lds + wave * (64 * 65);
    const int gw = blockIdx.x * 8 + wave, NGW = gridDim.x * 8;
    constexpr int T_IN = 32 * 80, T_OUT = 32 * 32, T_UP = 32 * 176, T_DN = 88 * 32, T_ALL = T_IN + T_OUT + T_UP + T_DN;
    for (int it = gw; it < T_ALL; it += NGW) {
        int r = it;
        if (r < T_IN) { transpose_tile(p->in[I_WIN] + (size_t)l * DM * NIN, DM, NIN, (bf16_t*)(p->ws + WS_WIN), scr, r, lane); continue; } r -= T_IN;
        if (r < T_OUT) { transpose_tile(p->in[I_WOUT] + (size_t)l * DM * DM, DM, DM, (bf16_t*)(p->ws + WS_WOUT), scr, r, lane); continue; } r -= T_OUT;
        if (r < T_UP) { transpose_tile(p->in[I_WUP] + (size_t)l * DM * NUP, DM, NUP, (bf16_t*)(p->ws + WS_WUP), scr, r, lane); continue; } r -= T_UP;
        transpose_tile(p->in[I_WDN] + (size_t)l * DFF * DM, DFF, DM, (bf16_t*)(p->ws + WS_WDN), scr, r, lane);
    }
}
__device__ __forceinline__ void adaln_phase(KP p, LAS unsigned char* lds) {
    if ((int)blockIdx.x >= 192) return;
    LAS float* scond = (LAS float*)lds;
    LAS float* red = (LAS float*)(lds + 98304);
    const int tid = opaque_tid(), w = tid >> 6, lane = tid & 63;
    for (int idx = tid; idx < 2048 * 9; idx += 512) { const int k = idx / 9, r = idx - k * 9;
        const float cv = r == 0 ? p->in[I_CCTX][k] : p->in[I_C][(r - 1) * 2048 + k]; scond[k * 12 + r] = silu_f(cv); }
    __syncthreads();
    float* mod = (float*)(p->ws + WS_MOD);
    for (int item = blockIdx.x; item < 192; item += gridDim.x) {
        const int l = item / 96, j = item - l * 96;
        const float* W = p->in[I_WADA] + (size_t)l * 2048 * 12288 + j * 128 + lane * 2;
        float acc[9][2];
#pragma unroll
        for (int r = 0; r < 9; ++r) { acc[r][0] = 0.f; acc[r][1] = 0.f; }
        const int k0 = w * 256;
#pragma unroll 8
        for (int k = k0; k < k0 + 256; ++k) {
            const f32x2 wv = *(const f32x2*)(W + (size_t)k * 12288);
            const f32x4 s0 = *(const LAS f32x4*)(scond + k * 12), s1 = *(const LAS f32x4*)(scond + k * 12 + 4), s2 = *(const LAS f32x4*)(scond + k * 12 + 8);
            acc[0][0] += s0[0] * wv[0]; acc[0][1] += s0[0] * wv[1]; acc[1][0] += s0[1] * wv[0]; acc[1][1] += s0[1] * wv[1];
            acc[2][0] += s0[2] * wv[0]; acc[2][1] += s0[2] * wv[1]; acc[3][0] += s0[3] * wv[0]; acc[3][1] += s0[3] * wv[1];
            acc[4][0] += s1[0] * wv[0]; acc[4][1] += s1[0] * wv[1]; acc[5][0] += s1[1] * wv[0]; acc[5][1] += s1[1] * wv[1];
            acc[6][0] += s1[2] * wv[0]; acc[6][1] += s1[2] * wv[1]; acc[7][0] += s1[3] * wv[0]; acc[7][1] += s1[3] * wv[1];
            acc[8][0] += s2[0] * wv[0]; acc[8][1] += s2[0] * wv[1];
        }
#pragma unroll
        for (int r = 0; r < 9; ++r) { red[(w * 18 + r * 2) * 64 + lane] = acc[r][0]; red[(w * 18 + r * 2 + 1) * 64 + lane] = acc[r][1]; }
        __syncthreads();
        for (int idx = tid; idx < 1152; idx += 512) { const int q = idx >> 6, ln = idx & 63; float s = 0.f;
#pragma unroll
            for (int ww = 0; ww < 8; ++ww) s += red[(ww * 18 + q) * 64 + ln];
            const int r = q >> 1, col = j * 128 + ln * 2 + (q & 1);
            mod[(size_t)(l * 9 + r) * 12288 + col] = s + p->in[I_BADA][l * 12288 + col]; }
        __syncthreads();
    }
}
__device__ __forceinline__ void filter_phase(KP p, LAS unsigned char* lds, int l) {
    LAS float* zb = (LAS float*)lds;
    LAS float* h1 = zb + 8 * 36;
    LAS float* h2 = h1 + 8 * 64;
    const int tid = opaque_tid();
    const float* w1 = p->in[I_HW1] + l * 33 * 64; const float* b1 = p->in[I_HB1] + l * 64; const float* fr = p->in[I_HFREQ] + l * 64;
    const float* w2 = p->in[I_HW2] + l * 64 * 64; const float* b2 = p->in[I_HB2] + l * 64; const float* w3 = p->in[I_HW3] + (size_t)l * 64 * 2048;
    for (int item = blockIdx.x; item < 160; item += gridDim.x) {
        const int g = item < 32 ? 0 : 1, tb = g ? item - 32 : item, L = g ? 1024 : 256;
        bf16_t* GF = (bf16_t*)(p->ws + (g ? WS_GF1 : WS_GF0));
        if (tid < 8 * 33) { const int tl = tid / 33, i = tid - tl * 33; const int t = tb * 8 + tl; float z;
            if (i == 0) z = (float)t / (float)(L - 1);
            else { const int fi = (i - 1) & 15; const float f = 1e-4f + (float)fi * ((15.0f - 1e-4f) / 15.0f); const float ang = (6.283185307179586f * (float)t / (float)L) * f;
                z = (i <= 16) ? cosf(ang) : -sinf(ang); }
            zb[tl * 36 + i] = z; }
        __syncthreads();
        { const int tl = tid >> 6, j = tid & 63; float s = b1[j];
#pragma unroll 1
          for (int i = 0; i < 33; ++i) s += zb[tl * 36 + i] * w1[i * 64 + j];
          h1[tl * 64 + j] = sinf(fr[j] * s); }
        __syncthreads();
        { const int tl = tid >> 6, j = tid & 63; float s = b2[j];
#pragma unroll 1
          for (int i = 0; i < 64; ++i) s += h1[tl * 64 + i] * w2[i * 64 + j];
          h2[tl * 64 + j] = sinf(fr[j] * s); }
        __syncthreads();
#pragma unroll 1
        for (int qq = 0; qq < 4; ++qq) { const int q = tid + 512 * qq; const int o = q >> 10, dir = (q >> 9) & 1, c = q & 511;
            float acc[8];
#pragma unroll
            for (int tl = 0; tl < 8; ++tl) acc[tl] = 0.f;
#pragma unroll 2
            for (int i = 0; i < 64; ++i) { const float wv = w3[(size_t)i * 2048 + q];
#pragma unroll
                for (int tl = 0; tl < 8; ++tl) acc[tl] += h2[tl * 64 + i] * wv; }
            const float a = -15.350567286626973f, b = -3.0701134573253945f; const float delta = fabsf(a + (float)c * ((b - a) / 511.0f));
            bf16_t* Gc = GF + ((size_t)o * 512 + c) * (2 * L);
#pragma unroll
            for (int tl = 0; tl < 8; ++tl) { const int t = tb * 8 + tl; const float tt = (float)t / (float)(L - 1); const float val = acc[tl] * __expf(-tt * delta);
                const int y = dir ? L + t + 1 : L - t; if (y < 2 * L) Gc[y] = (bf16_t)f2bf(val); }
            if (tb == 0 && dir == 0) Gc[0] = 0;
        }
        __syncthreads();
    }
}
__device__ __forceinline__ int mod_row(int r) { return r < MCTX ? 0 : 1 + ((r - MCTX) >> 10); }
__device__ __forceinline__ void mod0_phase(KP p) {
    const int tid = opaque_tid(), wave = tid >> 6, lane = tid & 63, gw = blockIdx.x * 8 + wave, NGW = gridDim.x * 8;
    const float* mod = (const float*)(p->ws + WS_MOD); bf16_t* H = (bf16_t*)(p->ws + WS_H);
    for (int r = gw; r < MROWS; r += NGW) {
        const float* x = r < MCTX ? p->in[I_XP] + (size_t)r * DM : p->in[I_XS] + (size_t)(r - MCTX) * DM;
        const float* mr = mod + (size_t)mod_row(r) * 12288;
#pragma unroll
        for (int j = 0; j < 8; ++j) { const int c = (lane + 64 * j) * 4; const f32x4 v = *(const f32x4*)(x + c), sh = *(const f32x4*)(mr + c), sc = *(const f32x4*)(mr + 2048 + c);
            const f32x4 h = v * (sc + 1.0f) + sh; u32x2 o; o.x = pk2(h[0], h[1]); o.y = pk2(h[2], h[3]); *(u32x2*)(H + (size_t)r * DM + c) = o; }
    }
}
__device__ __forceinline__ void ln_phase(KP p, const float* lw, const float* lb, const float* mod_next) {
    const int tid = opaque_tid(), wave = tid >> 6, lane = tid & 63, gw = blockIdx.x * 8 + wave, NGW = gridDim.x * 8;
    float* Y = p->out; bf16_t* H = (bf16_t*)(p->ws + WS_H);
    for (int r = gw; r < MROWS; r += NGW) {
        float* y = Y + (size_t)r * DM; f32x4 v[8]; float s = 0.f;
#pragma unroll
        for (int j = 0; j < 8; ++j) { v[j] = *(const f32x4*)(y + (lane + 64 * j) * 4); s += (v[j][0] + v[j][1]) + (v[j][2] + v[j][3]); }
        const float mean = wave_sum(s) * (1.f / DM); float q = 0.f;
#pragma unroll
        for (int j = 0; j < 8; ++j) { v[j] = v[j] - mean; q += (v[j][0] * v[j][0] + v[j][1] * v[j][1]) + (v[j][2] * v[j][2] + v[j][3] * v[j][3]); }
        const float rstd = 1.0f / sqrtf(wave_sum(q) * (1.f / DM) + 1e-6f);
        const float* mr = mod_next ? mod_next + (size_t)mod_row(r) * 12288 : nullptr;
#pragma unroll
        for (int j = 0; j < 8; ++j) { const int c = (lane + 64 * j) * 4; const f32x4 w = *(const f32x4*)(lw + c), b = *(const f32x4*)(lb + c);
            const f32x4 o = v[j] * rstd * w + b; *(f32x4*)(y + c) = o;
            if (mod_next) { const f32x4 sh = *(const f32x4*)(mr + c), sc = *(const f32x4*)(mr + 2048 + c); const f32x4 h = o * (sc + 1.0f) + sh;
                u32x2 ob; ob.x = pk2(h[0], h[1]); ob.y = pk2(h[2], h[3]); *(u32x2*)(H + (size_t)r * DM + c) = ob; } }
    }
}
__device__ __forceinline__ void gate_phase(KP p, int l) {
    const bf16_t* UP = (const bf16_t*)(p->ws + WS_UP); bf16_t* ACT = (bf16_t*)(p->ws + WS_ACT);
    const float* cw = p->in[I_FFNCONV] + (size_t)l * 3 * NUP;
    const int gt = blockIdx.x * 512 + opaque_tid(), GT = gridDim.x * 512;
    for (int u = gt; u < 704 * 384; u += GT) {
        const int rs = u / 704, cg = u - rs * 704, c0 = cg * 8, r0 = rs * 32;
        const int Lseq = r0 < MCTX ? 256 : 1024; const int t0 = (r0 < MCTX ? r0 : r0 - MCTX) & (Lseq - 1);
        float wg[3][8], wu[3][8];
#pragma unroll
        for (int k = 0; k < 3; ++k) { const f32x4 a0 = *(const f32x4*)(cw + k * NUP + c0), a1 = *(const f32x4*)(cw + k * NUP + c0 + 4), b0 = *(const f32x4*)(cw + k * NUP + DFF + c0), b1 = *(const f32x4*)(cw + k * NUP + DFF + c0 + 4);
#pragma unroll
            for (int e = 0; e < 4; ++e) { wg[k][e] = a0[e]; wg[k][4 + e] = a1[e]; wu[k][e] = b0[e]; wu[k][4 + e] = b1[e]; } }
        float gp[8], gc[8], gn[8], up_[8], uc[8], un[8];
        auto ld = [&](int r, float* gd, float* ud, bool valid) {
            if (valid) { const u32x4 a = *(const u32x4*)(UP + (size_t)r * NUP + c0), b = *(const u32x4*)(UP + (size_t)r * NUP + DFF + c0);
                gd[0] = bflo(a.x); gd[1] = bfhi(a.x); gd[2] = bflo(a.y); gd[3] = bfhi(a.y); gd[4] = bflo(a.z); gd[5] = bfhi(a.z); gd[6] = bflo(a.w); gd[7] = bfhi(a.w);
                ud[0] = bflo(b.x); ud[1] = bfhi(b.x); ud[2] = bflo(b.y); ud[3] = bfhi(b.y); ud[4] = bflo(b.z); ud[5] = bfhi(b.z); ud[6] = bflo(b.w); ud[7] = bfhi(b.w); }
            else {
#pragma unroll
                for (int e = 0; e < 8; ++e) { gd[e] = 0.f; ud[e] = 0.f; } } };
        ld(r0 - 1, gp, up_, t0 > 0); ld(r0, gc, uc, true);
        for (int i = 0; i < 32; ++i) {
            ld(r0 + i + 1, gn, un, t0 + i + 1 < Lseq);
            float o[8];
#pragma unroll
            for (int e = 0; e < 8; ++e) { const float G = wg[0][e] * gp[e] + wg[1][e] * gc[e] + wg[2][e] * gn[e], U = wu[0][e] * up_[e] + wu[1][e] * uc[e] + wu[2][e] * un[e];
                o[e] = silu_f(G) * U; gp[e] = gc[e]; gc[e] = gn[e]; up_[e] = uc[e]; uc[e] = un[e]; }
            u32x4 w; w.x = pk2(o[0], o[1]); w.y = pk2(o[2], o[3]); w.z = pk2(o[4], o[5]); w.w = pk2(o[6], o[7]);
            *(u32x4*)(ACT + (size_t)(r0 + i) * DFF + c0) = w;
        }
    }
}
__device__ __forceinline__ void prep_phase(KP p, int l) {
    const int tid = opaque_tid(), wave = tid >> 6, lane = tid & 63, gw = blockIdx.x * 8 + wave, NGW = gridDim.x * 8;
    const int gt = blockIdx.x * 512 + tid, GT = gridDim.x * 512;
    const bf16_t* PROJ = (const bf16_t*)(p->ws + WS_PROJ);
    bf16_t* QN = (bf16_t*)(p->ws + WS_QN); bf16_t* KBL = (bf16_t*)(p->ws + WS_KBL); bf16_t* VBL = (bf16_t*)(p->ws + WS_VBL); bf16_t* KBC = (bf16_t*)(p->ws + WS_KBC); bf16_t* VBC = (bf16_t*)(p->ws + WS_VBC);
    const float* qnw = p->in[I_QN] + l * 128; const float* knw = p->in[I_KN] + l * 128;
    const float invf = exp2f(-(float)(lane & 31) * (13.287712379549449f / 32.0f));
    for (int u = gw; u < MROWS * 10; u += NGW) {
        const int r = u / 10, hh = u - r * 10; const bool isq = hh < 8; const int kvh = hh - 8;
        const bf16_t* src = PROJ + (size_t)r * NIN + (isq ? hh * 128 : 1024 + kvh * 128);
        const float v0 = bf2f(src[lane]), v1 = bf2f(src[lane + 64]);
        const float ss = wave_sum(v0 * v0 + v1 * v1); const float rinv = 1.0f / sqrtf(ss * (1.f / 128.f) + 1e-6f);
        const float* nw = isq ? qnw : knw;
        const float y0 = v0 * rinv * nw[lane], y1 = v1 * rinv * nw[lane + 64];
        float o0 = y0, o1 = y1;
        const bool lat = r >= MCTX; const int rl = lat ? r - MCTX : r; const int b = lat ? rl >> 10 : rl >> 8; const int t = lat ? rl & 1023 : rl & 255;
        if (lat) { const float pos = (lane < 32) ? (float)(t >> 6) : (float)(t & 63); const float ang = pos * invf; const float cs = cosf(ang), sn = sinf(ang);
            o0 = y0 * cs - y1 * sn; o1 = y0 * sn + y1 * cs; }
        if (isq) { bf16_t* d = QN + (size_t)r * 1024 + hh * 128; d[lane] = (bf16_t)f2bf(o0); d[lane + 64] = (bf16_t)f2bf(o1); }
        else {
            const float w0 = bf2f(src[256 + lane]), w1 = bf2f(src[256 + lane + 64]);
            if (lat) { bf16_t* dk = KBL + ((size_t)(b * 2 + kvh) * 1536 + 512 + t) * 128; bf16_t* dv = VBL + ((size_t)(b * 2 + kvh) * 1536 + 512 + t) * 128;
                dk[lane] = (bf16_t)f2bf(o0); dk[lane + 64] = (bf16_t)f2bf(o1); dv[lane] = src[256 + lane]; dv[lane + 64] = src[256 + lane + 64]; }
            else { bf16_t* dk = KBC + ((size_t)(b * 2 + kvh) * 256 + t) * 128; bf16_t* dv = VBC + ((size_t)(b * 2 + kvh) * 256 + t) * 128;
                dk[lane] = (bf16_t)f2bf(y0); dk[lane + 64] = (bf16_t)f2bf(y1); dv[lane] = src[256 + lane]; dv[lane + 64] = src[256 + lane + 64];
                float* ck = p->out + OUT_CK + ((size_t)((b * 2 + l) * 2 + kvh) * 256 + t) * 128; float* cv = p->out + OUT_CV + ((size_t)((b * 2 + l) * 2 + kvh) * 256 + t) * 128;
                ck[lane] = y0; ck[lane + 64] = y1; cv[lane] = w0; cv[lane + 64] = w1; }
        }
    }
    for (int u = gt; u < 8 * 2 * 512 * 16 * 2; u += GT) {
        const int kv = u & 1, e = u >> 1; const int cgp = e & 15, j = (e >> 4) & 511, kvh = (e >> 13) & 1, b = e >> 14;
        const float* src = p->in[kv ? I_CV : I_CK] + ((size_t)((b * 2 + l) * 2 + kvh) * 512 + j) * 128 + cgp * 8;
        const f32x4 a = *(const f32x4*)src, c = *(const f32x4*)(src + 4);
        u32x4 o; o.x = pk2(a[0], a[1]); o.y = pk2(a[2], a[3]); o.z = pk2(c[0], c[1]); o.w = pk2(c[2], c[3]);
        *(u32x4*)((kv ? VBL : KBL) + ((size_t)(b * 2 + kvh) * 1536 + j) * 128 + cgp * 8) = o;
    }
    bf16_t* KEL = (bf16_t*)(p->ws + WS_KEL); bf16_t* VEL = (bf16_t*)(p->ws + WS_VEL); bf16_t* KEC = (bf16_t*)(p->ws + WS_KEC); bf16_t* VEC = (bf16_t*)(p->ws + WS_VEC);
    for (int u = gt; u < 8 * 4 * 1280 * 16; u += GT) {
        const int cgp = u & 15; const int e = u >> 4; const int i = e % 1280, bh = e / 1280, h = bh & 3, b = bh >> 2;
        u32x4 ko, vo;
        if (i < 256) { const int dd = i & 127; ko = (u32x4){0u, 0u, 0u, 0u};
            if ((dd >> 3) == cgp) { const unsigned one = (dd & 1) ? 0x3F800000u : 0x00003F80u; const int wsel = (dd & 7) >> 1; ko.x = wsel == 0 ? one : 0u; ko.y = wsel == 1 ? one : 0u; ko.z = wsel == 2 ? one : 0u; ko.w = wsel == 3 ? one : 0u; }
            const float* st = p->in[I_ST] + ((size_t)(((b * 2 + l) * 2 + (i >> 7)) * 4 + h) * 128 + dd) * 128 + cgp * 8;
            const f32x4 a = *(const f32x4*)st, c = *(const f32x4*)(st + 4);
            vo.x = pk2(a[0], a[1]); vo.y = pk2(a[2], a[3]); vo.z = pk2(c[0], c[1]); vo.w = pk2(c[2], c[3]); }
        else { const bf16_t* src = PROJ + (size_t)(MCTX + b * 1024 + (i - 256)) * NIN + 2048 + h * 128 + cgp * 8;
            ko = *(const u32x4*)src; vo = *(const u32x4*)(src + 512); }
        *(u32x4*)(KEL + (size_t)e * 128 + cgp * 8) = ko; *(u32x4*)(VEL + (size_t)e * 128 + cgp * 8) = vo;
    }
    for (int u = gt; u < 16 * 4 * 256 * 16; u += GT) {
        const int cgp = u & 15; const int e = u >> 4; const int t = e & 255, bh = e >> 8, h = bh & 3, b = bh >> 2;
        const bf16_t* src = PROJ + (size_t)(b * 256 + t) * NIN + 2048 + h * 128 + cgp * 8;
        *(u32x4*)(KEC + (size_t)e * 128 + cgp * 8) = *(const u32x4*)src; *(u32x4*)(VEC + (size_t)e * 128 + cgp * 8) = *(const u32x4*)(src + 512);
    }
    bf16_t* HYT = (bf16_t*)(p->ws + WS_HYT); const float* hc = p->in[I_HYCONV] + (size_t)l * 3 * 1536;
    for (int u = gw; u < 192 * 24; u += NGW) {
        const int rb = u / 24, cb = u - rb * 24, ch = cb * 64 + lane, r0 = rb * 64;
        const int Lseq = r0 < MCTX ? 256 : 1024; const int t0 = (r0 < MCTX ? r0 : r0 - MCTX) & (Lseq - 1);
        const float w0 = hc[ch], w1 = hc[1536 + ch], w2 = hc[3072 + ch];
        const bf16_t* src = PROJ + (size_t)r0 * NIN + 3584 + ch;
        float xp = t0 > 0 ? bf2f(*(src - NIN)) : 0.f, xc = bf2f(*src);
        unsigned pk[32];
#pragma unroll
        for (int i = 0; i < 64; i += 2) {
            const float xn = bf2f(src[(size_t)(i + 1) * NIN]);
            const float ya = w0 * xp + w1 * xc + w2 * xn;
            const float xn2 = (t0 + i + 2 < Lseq) ? bf2f(src[(size_t)(i + 2) * NIN]) : 0.f;
            const float yb = w0 * xc + w1 * xn + w2 * xn2;
            pk[i >> 1] = pk2(ya, yb); xp = xn; xc = xn2;
        }
        bf16_t* dst = HYT + (size_t)ch * MROWS + r0;
#pragma unroll
        for (int i = 0; i < 8; ++i) { u32x4 o; o.x = pk[4 * i]; o.y = pk[4 * i + 1]; o.z = pk[4 * i + 2]; o.w = pk[4 * i + 3]; *(u32x4*)(dst + 8 * i) = o; }
    }
}
template <int TPW, int NB>
__device__ __forceinline__ void hyena_item(KP p, LAS unsigned char* lds, int c, int l) {
    constexpr int L = TPW * 128, CS = 2 * L + 16, RS = L + 8, ROWBASE = (NB == 8) ? MCTX : 0;
    LAS bf16_t* gc = (LAS bf16_t*)lds; LAS bf16_t* U0 = gc + 8 * CS; LAS bf16_t* U1 = U0 + NB * RS;
    const int tid = opaque_tid(), w = tid >> 6, lane = tid & 63, i = lane & 15, kq = lane >> 4;
    const bf16_t* hyt = (const bf16_t*)(p->ws + WS_HYT) + (size_t)c * MROWS + ROWBASE;
    const bf16_t* GF = (const bf16_t*)(p->ws + (NB == 8 ? WS_GF1 : WS_GF0));
    bf16_t* CC = (bf16_t*)(p->ws + WS_CONCAT);
    for (int idx = tid * 8; idx < NB * L; idx += 512 * 8) { const int b = idx / L, m = idx - b * L; *(LAS u32x4*)(U0 + b * RS + m) = *(const u32x4*)(hyt + idx); }
#pragma unroll 1
    for (int o = 0; o < 2; ++o) {
        const bf16_t* G = GF + ((size_t)o * 512 + c) * (2 * L);
        for (int idx = tid; idx < 8 * 2 * L; idx += 512) { const int s = idx / (2 * L), y = idx - s * (2 * L); gc[s * CS + y] = (y >= s) ? G[y - s] : (bf16_t)0; }
        __syncthreads();
        const LAS bf16_t* Uin = o ? U1 : U0;
        f32x4 acc[TPW];
#pragma unroll
        for (int t = 0; t < TPW; ++t) acc[t] = (f32x4){0.f, 0.f, 0.f, 0.f};
        const LAS bf16_t* bp = Uin + (i & (NB - 1)) * RS + kq * 8;
        const LAS bf16_t* ap = gc + (i & 7) * CS + kq * 8 - (i & 8) + L - w * TPW * 16;
#pragma unroll 2
        for (int m0 = 0; m0 < L; m0 += 32) {
            const bf16x8 B = *(const LAS bf16x8*)(bp + m0);
#pragma unroll
            for (int t = 0; t < TPW; ++t) { const bf16x8 A = *(const LAS bf16x8*)(ap + m0 - t * 16); acc[t] = __builtin_amdgcn_mfma_f32_16x16x32_bf16(A, B, acc[t], 0, 0, 0); }
        }
        const float bias = p->in[I_HYBIAS][(l * 2 + o) * 512 + c];
        const int b = i, rq = kq;
        if (b < NB) {
#pragma unroll
            for (int t = 0; t < TPW; ++t) { const int n = (w * TPW + t) * 16 + rq * 4;
                const u32x2 vin = *(const LAS u32x2*)(Uin + b * RS + n); const u32x2 xg = *(const u32x2*)(hyt + (size_t)(1 + o) * 512 * MROWS + b * L + n);
                const float z0 = bflo(xg.x) * (acc[t][0] + bflo(vin.x) * bias), z1 = bfhi(xg.x) * (acc[t][1] + bfhi(vin.x) * bias),
                            z2 = bflo(xg.y) * (acc[t][2] + bflo(vin.y) * bias), z3 = bfhi(xg.y) * (acc[t][3] + bfhi(vin.y) * bias);
                if (o == 0) { u32x2 zo; zo.x = pk2(z0, z1); zo.y = pk2(z2, z3); *(LAS u32x2*)(U1 + b * RS + n) = zo; }
                else { bf16_t* d = CC + (size_t)(ROWBASE + b * L + n) * DM + 1536 + c; d[0] = (bf16_t)f2bf(z0); d[DM] = (bf16_t)f2bf(z1); d[2 * DM] = (bf16_t)f2bf(z2); d[3 * DM] = (bf16_t)f2bf(z3); } }
        }
        __syncthreads();
    }
}
__device__ __forceinline__ float log2_sigmoid(float x) { return -log1pf(__expf(-x)) * 1.4426950408889634f; }
__device__ __forceinline__ void mix_phase(KP p, LAS unsigned char* ldsl, char* ldsg, int l) {
    unsigned* ctr = (unsigned*)(p->ws + WS_CTL) + 64 * (1 + l);
    LAS int* s_item = (LAS int*)(ldsl + LDS_ITEM_OFF);
    const bf16_t* PROJ = (const bf16_t*)(p->ws + WS_PROJ); bf16_t* CC = (bf16_t*)(p->ws + WS_CONCAT);
    const bf16_t* QN = (const bf16_t*)(p->ws + WS_QN);
    const float* rd = p->in[I_RDEC] + l * 8;
    for (;;) {
        if (threadIdx.x == 0) *s_item = (int)atomicAdd(ctr, 1u);
        __syncthreads();
        const int it = *s_item;
        __syncthreads();
        if (it >= 1664) break;
        if (it < 256 || (it >= 896 && it < 1024)) {
            const bool lat = it < 256; const int j = lat ? it : it - 896;
            const int b = lat ? j >> 5 : j >> 3, h = lat ? (j >> 2) & 7 : j & 7, qb = lat ? j & 3 : 0;
            const size_t row = lat ? (size_t)(MCTX + b * 1024 + qb * 256) : (size_t)b * 256; const int seq = lat ? 1536 : 256;
            const size_t kvo = (size_t)(b * 2 + (h >> 2)) * seq * 128;
            att::attn_dense_body<1024, 128, 2048>(QN + row * 1024 + h * 128, (const bf16_t*)(p->ws + (lat ? WS_KBL : WS_KBC)) + kvo, (const bf16_t*)(p->ws + (lat ? WS_VBL : WS_VBC)) + kvo,
                CC + row * DM + h * 128, seq, ldsg);
        } else if (it < 384 || (it >= 1024 && it < 1088)) {
            const bool lat = it < 384; const int j = lat ? it - 256 : it - 1024;
            const int b = lat ? j >> 4 : j >> 2, h = lat ? (j >> 2) & 3 : j & 3, qb = lat ? j & 3 : 0;
            const size_t row = lat ? (size_t)(MCTX + b * 1024 + qb * 256) : (size_t)b * 256; const int seq = lat ? 1280 : 256;
            const size_t kvo = (size_t)(b * 4 + h) * seq * 128;
            att::retn_body<0, NIN>(PROJ + row * NIN + 1536 + h * 128, (const bf16_t*)(p->ws + (lat ? WS_KEL : WS_KEC)) + kvo, (const bf16_t*)(p->ws + (lat ? WS_VEL : WS_VEC)) + kvo,
                seq, lat ? 4 : 0, qb * 256, lat ? 1024 : 256, log2_sigmoid(rd[h]), log2_sigmoid(rd[4 + h]), PROJ + row * NIN + 3072 + h * 128, CC + row * DM + 1024 + h * 128, nullptr, ldsg);
        } else if (it < 896) {
            hyena_item<8, 8>(p, ldsl, it - 384, l);
        } else if (it < 1152) {
            const int j = it - 1088, b = j >> 2, h = j & 3;
            att::retn_body<1, NIN>((const bf16_t*)(p->ws + WS_IDQ), (const bf16_t*)(p->ws + WS_KEC) + (size_t)(b * 4 + h) * 256 * 128, (const bf16_t*)(p->ws + WS_VEC) + (size_t)(b * 4 + h) * 256 * 128,
                256, 0, 0, 256, log2_sigmoid(rd[h]), log2_sigmoid(rd[4 + h]), nullptr, nullptr, p->out + OUT_ST + (size_t)((b * 2 + l) * 2 * 4 + h) * 16384, ldsg);
        } else {
            hyena_item<2, 16>(p, ldsl, it - 1152, l);
        }
    }
}
__global__ void __launch_bounds__(512, 2) mega(Params p_unused) {
    extern __shared__ __attribute__((aligned(16))) unsigned char lds[];
    cg::grid_group grid = cg::this_grid();
    LAS unsigned char* ldsl = (LAS unsigned char*)lds;
    const int G = gridDim.x;
    KP p = kp_fresh();
    if (blockIdx.x == 0 && threadIdx.x < 8) ((unsigned*)(p->ws + WS_CTL))[64 * threadIdx.x] = 0u;
    { bf16_t* IDQ = (bf16_t*)(p->ws + WS_IDQ);
      for (int u = blockIdx.x * 512 + threadIdx.x; u < 256 * 128; u += G * 512) { const int n = u >> 7, j = u & 127; IDQ[(size_t)n * NIN + j] = (j == (n & 127)) ? (bf16_t)0x3F80 : (bf16_t)0; } }
    adaln_phase(kp_fresh(), ldsl);
    __syncthreads();
    convert_weights(kp_fresh(), ldsl, 0);
    __syncthreads();
    filter_phase(kp_fresh(), ldsl, 0);
    grid.sync();
    mod0_phase(kp_fresh());
    grid.sync();
#pragma unroll 1
    for (int l = 0; l < 2; ++l) {
        { KP q = kp_fresh(); pg8::Gemm g{(const bf16_t*)(q->ws + WS_H), (const bf16_t*)(q->ws + WS_WIN), MROWS, NIN, DM}; pg8::StaticOrder S; S.init(MROWS, NIN, G, (int)blockIdx.x);
          pg8::EpiBf16 E{(bf16_t*)(q->ws + WS_PROJ), NIN}; pg8::gemm_phase<pg8::EpiBf16, pg8::StaticOrder>(ldsl, g, S, E, nullptr); }
        grid.sync();
        prep_phase(kp_fresh(), l);
        grid.sync();
        mix_phase(kp_fresh(), ldsl, (char*)lds, l);
        grid.sync();
        { KP q = kp_fresh(); pg8::Gemm g{(const bf16_t*)(q->ws + WS_CONCAT), (const bf16_t*)(q->ws + WS_WOUT), MROWS, DM, DM}; pg8::StaticOrder S; S.init(MROWS, DM, G, (int)blockIdx.x);
          pg8::EpiResid E{l == 0 ? q->in[I_XP] : q->out, l == 0 ? q->in[I_XS] : q->out + (size_t)MCTX * DM, q->out, (const float*)(q->ws + WS_MOD) + (size_t)l * 9 * 12288 + 2 * 2048, 1.41421356237f};
          pg8::gemm_phase<pg8::EpiResid, pg8::StaticOrder>(ldsl, g, S, E, nullptr); }
        grid.sync();
        { KP q = kp_fresh(); ln_phase(q, q->in[I_LN1W] + l * DM, q->in[I_LN1B] + l * DM, (const float*)(q->ws + WS_MOD) + (size_t)l * 9 * 12288 + 3 * 2048); }
        grid.sync();
        { KP q = kp_fresh(); pg8::Gemm g{(const bf16_t*)(q->ws + WS_H), (const bf16_t*)(q->ws + WS_WUP), MROWS, NUP, DM}; pg8::StaticOrder S; S.init(MROWS, NUP, G, (int)blockIdx.x);
          pg8::EpiBf16 E{(bf16_t*)(q->ws + WS_UP), NUP}; pg8::gemm_phase<pg8::EpiBf16, pg8::StaticOrder>(ldsl, g, S, E, nullptr); }
        grid.sync();
        gate_phase(kp_fresh(), l);
        grid.sync();
        { KP q = kp_fresh(); pg8::Gemm g{(const bf16_t*)(q->ws + WS_ACT), (const bf16_t*)(q->ws + WS_WDN), MROWS, DM, DFF}; pg8::StaticOrder S; S.init(MROWS, DM, G, (int)blockIdx.x);
          pg8::EpiResid E{q->out, q->out + (size_t)MCTX * DM, q->out, (const float*)(q->ws + WS_MOD) + (size_t)l * 9 * 12288 + 5 * 2048, 1.41421356237f};
          pg8::gemm_phase<pg8::EpiResid, pg8::StaticOrder>(ldsl, g, S, E, nullptr); }
        grid.sync();
        { KP q = kp_fresh(); ln_phase(q, q->in[I_LN2W] + l * DM, q->in[I_LN2B] + l * DM, l == 0 ? (const float*)(q->ws + WS_MOD) + (size_t)9 * 12288 : nullptr); }
        if (l == 0) { __syncthreads(); convert_weights(kp_fresh(), ldsl, 1); __syncthreads(); filter_phase(kp_fresh(), ldsl, 1); grid.sync(); }
    }
}
extern "C" void kernel_launch(void* const* d_in, const int* in_sizes, int n_in, void* d_out, int out_size, void* d_ws, size_t ws_size, hipStream_t stream) {
    static int grid = 0;
    if (grid == 0) {
        if (n_in != 29 || out_size != 33554432 || ws_size < WS_END) { fprintf(stderr, "kernel_launch: unexpected shapes: n_in %d out %d ws %zu (need %zu)\n", n_in, out_size, ws_size, (size_t)WS_END); grid = -1; return; }
        int dev = 0, cus = 0, per_cu = 0;
        (void)hipGetDevice(&dev); (void)hipDeviceGetAttribute(&cus, hipDeviceAttributeMultiprocessorCount, dev);
        if (hipFuncSetAttribute((const void*)mega, hipFuncAttributeMaxDynamicSharedMemorySize, LDS_BYTES) != hipSuccess) { fprintf(stderr, "kernel_launch: hipFuncSetAttribute failed\n"); grid = -1; return; }
        if (hipOccupancyMaxActiveBlocksPerMultiprocessor(&per_cu, (const void*)mega, 512, LDS_BYTES) != hipSuccess || per_cu < 1) { fprintf(stderr, "kernel_launch: occupancy query says %d\n", per_cu); per_cu = 1; }
        (void)hipGetLastError();
        grid = cus > 0 ? cus : 256;
    }
    if (grid < 0) return;
    Params p{};
    for (int i = 0; i < 29; ++i) p.in[i] = (const float*)d_in[i];
    p.out = (float*)d_out; p.ws = (unsigned char*)d_ws; p.pad = 0ull;
    void* args[] = {&p};
    const hipError_t e = hipLaunchCooperativeKernel((const void*)mega, dim3(grid), dim3(512), args, LDS_BYTES, stream);
    if (e != hipSuccess) fprintf(stderr, "kernel_launch: cooperative launch failed: %s (grid %d)\n", hipGetErrorString(e), grid);
}
```

```cpp
#include <hip/hip_runtime.h>
#include <hip/hip_cooperative_groups.h>
#include <cstdio>
#include <cstdint>
namespace cg = cooperative_groups;
__device__ __forceinline__ int opaque_tid() { int t = threadIdx.x; asm volatile("" : "+v"(t)); return t; }
__device__ __forceinline__ int opaque_s(int v) { asm volatile("" : "+s"(v)); return v; }
namespace pg8 {
#define PG8_LAS __attribute__((address_space(3)))
typedef unsigned short bf16_t;
typedef short bf16x8 __attribute__((ext_vector_type(8)));
typedef float f32x4 __attribute__((ext_vector_type(4)));
typedef float f32x2 __attribute__((ext_vector_type(2)));
typedef unsigned u32x4 __attribute__((ext_vector_type(4)));
constexpr int BM = 256, BK = 64, HALF = 128, HTB = HALF * BK * 2  , STAGE_BYTES = 8 * HTB, NXCD = 8, WGM = 8;

__host__ __device__ __forceinline__ int lds_byte(int r, int c) { const int st = (r >> 4) * 2 + (c >> 5), rr = r & 15, cc = c & 31, ob = rr * 64 + cc * 2; return st * 1024 + (ob ^ (((ob >> 9) & 1) << 5)); }
__host__ __device__ __forceinline__ void stage_rc(int b, int& R, int& C) { const int st = b / 1024, sb = b % 1024, swz = sb ^ (((sb >> 9) & 1) << 5); R = (st >> 1) * 16 + swz / 64; C = (st & 1) * 32 + (swz % 64) / 2; }
__host__ __device__ __forceinline__ int perm32(int rho) { const int n = rho >> 4, i = rho & 15; return 8 * (i >> 2) + 4 * n + (i & 3); }

struct Unit { int pm, pn; };
struct Gemm { const bf16_t* A; const bf16_t* Bt; int M, N, K; };

struct StaticOrder {
    int nM, nN, nwg, G, c;
    __host__ __device__ void init(int M, int N, int G_, int c_) { nM = M / BM; nN = N / BM; nwg = nM * nN; G = G_; c = c_; }
    __host__ __device__ bool next(int i, Unit& u) const {
        const long L = (long)i * G + c; if (L >= nwg) return false;
        int wgid = (int)L; { const int q = nwg / NXCD, r = nwg % NXCD, xcd = wgid % NXCD, off = wgid / NXCD; wgid = (xcd < r ? xcd * (q + 1) : r * (q + 1) + (xcd - r) * q) + off; }
        const int nig = WGM * nN, gid = wgid / nig, fm = gid * WGM, gsz = (nM - fm) < WGM ? (nM - fm) : WGM;
        u.pm = fm + ((wgid % nig) % gsz); u.pn = (wgid % nig) / gsz; return true;
    }
    __device__ __forceinline__ void a_ready(const Unit&) const {}
    __device__ __forceinline__ void done(const Unit&) const {}
};
__device__ __forceinline__ unsigned cvt_pk_bf16(float lo, float hi) { unsigned r; asm volatile("v_cvt_pk_bf16_f32 %0, %1, %2" : "=v"(r) : "v"(lo), "v"(hi)); return r; }
struct EpiBf16 {
    static constexpr bool PERM = true, AFTER_DRAIN = false;
    bf16_t* O; int ldc;
    __device__ __forceinline__ void operator()(const f32x4 (&acc)[2][2][4][2], const Unit& u, int wr, int wc, int fr, int fq) const {
        const int row0 = u.pm * BM + wr * 64 + fr, col0 = u.pn * BM + wc * 32 + 8 * fq;
#pragma unroll
        for (int ai = 0; ai < 2; ++ai) {
#pragma unroll
            for (int m = 0; m < 4; ++m) { bf16_t* rowp = O + (size_t)(row0 + ai * HALF + m * 16) * ldc + col0;
#pragma unroll
                for (int bj = 0; bj < 2; ++bj) { const f32x4 v0 = acc[ai][bj][m][0], v1 = acc[ai][bj][m][1];
                    u32x4 w; w.x = cvt_pk_bf16(v0[0], v0[1]); w.y = cvt_pk_bf16(v0[2], v0[3]); w.z = cvt_pk_bf16(v1[0], v1[1]); w.w = cvt_pk_bf16(v1[2], v1[3]);
                    *(u32x4*)(rowp + bj * HALF) = w; } } }
    }
};

__device__ __forceinline__ float dpp_ror1(float v) { return __builtin_bit_cast(float, __builtin_amdgcn_update_dpp(0, __builtin_bit_cast(int, v), 0x121, 0xf, 0xf, false)); }
__device__ __forceinline__ float dpp_ror15(float v) { return __builtin_bit_cast(float, __builtin_amdgcn_update_dpp(0, __builtin_bit_cast(int, v), 0x12f, 0xf, 0xf, false)); }
typedef unsigned u32x2e __attribute__((ext_vector_type(2)));
struct EpiGate {
    static constexpr bool PERM = true, AFTER_DRAIN = false;
    bf16_t* ACT; bf16_t* STASH; const float* cw;
    __device__ __forceinline__ void operator()(const f32x4 (&acc)[2][2][4][2], const Unit& u, int wr, int wc, int fr, int fq) const {
        const int chb = u.pn * 128 + wc * 32 + 8 * fq;
        const int rowg = u.pm * BM + wr * 64;
        f32x4 cwv[2][6];
#pragma unroll
        for (int n = 0; n < 2; ++n) { const int ch = chb + 4 * n;
            cwv[n][0] = *(const f32x4*)(cw + ch); cwv[n][1] = *(const f32x4*)(cw + 11264 + ch); cwv[n][2] = *(const f32x4*)(cw + 2 * 11264 + ch);
            cwv[n][3] = *(const f32x4*)(cw + 5632 + ch); cwv[n][4] = *(const f32x4*)(cw + 11264 + 5632 + ch); cwv[n][5] = *(const f32x4*)(cw + 2 * 11264 + 5632 + ch); }
#pragma unroll
        for (int ai = 0; ai < 2; ++ai)
#pragma unroll
            for (int m = 0; m < 4; ++m) {
                float o[2][4];
#pragma unroll
                for (int n = 0; n < 2; ++n) {
                    const f32x4 g0 = cwv[n][0], g1 = cwv[n][1], g2 = cwv[n][2], u0 = cwv[n][3], u1 = cwv[n][4], u2 = cwv[n][5];
                    const f32x4 gc = acc[ai][0][m][n], uc = acc[ai][1][m][n];
                    const f32x4 gl = acc[ai][0][m > 0 ? m - 1 : 0][n], ul = acc[ai][1][m > 0 ? m - 1 : 0][n], gh = acc[ai][0][m < 3 ? m + 1 : 3][n], uh = acc[ai][1][m < 3 ? m + 1 : 3][n];
#pragma unroll
                    for (int j = 0; j < 4; ++j) {
                        const float gp = dpp_ror1(fr == 15 ? gl[j] : gc[j]), gn = dpp_ror15(fr == 0 ? gh[j] : gc[j]);
                        const float up = dpp_ror1(fr == 15 ? ul[j] : uc[j]), un = dpp_ror15(fr == 0 ? uh[j] : uc[j]);
                        const float G = g0[j] * gp + g1[j] * gc[j] + g2[j] * gn, U = u0[j] * up + u1[j] * uc[j] + u2[j] * un;
                        o[n][j] = G * __builtin_amdgcn_rcpf(1.f + __expf(-G)) * U; }
                }
                const int rho = m * 16 + fr, row = rowg + ai * HALF + rho;
                if (rho != 0 && rho != 63) { u32x4 w; w.x = cvt_pk_bf16(o[0][0], o[0][1]); w.y = cvt_pk_bf16(o[0][2], o[0][3]); w.z = cvt_pk_bf16(o[1][0], o[1][1]); w.w = cvt_pk_bf16(o[1][2], o[1][3]);
                    *(u32x4*)(ACT + (size_t)row * 5632 + chb) = w; }
                if (rho <= 1 || rho >= 62) { const int slot = rho <= 1 ? rho : rho - 60; bf16_t* sp = STASH + ((size_t)((row >> 6) * 4 + slot) * 2) * 5632 + chb;
                    const f32x4 ga = acc[ai][0][m][0], gb = acc[ai][0][m][1], ua = acc[ai][1][m][0], ub = acc[ai][1][m][1];
                    u32x4 a; a.x = cvt_pk_bf16(ga[0], ga[1]); a.y = cvt_pk_bf16(ga[2], ga[3]); a.z = cvt_pk_bf16(gb[0], gb[1]); a.w = cvt_pk_bf16(gb[2], gb[3]); *(u32x4*)sp = a;
                    u32x4 b; b.x = cvt_pk_bf16(ua[0], ua[1]); b.y = cvt_pk_bf16(ua[2], ua[3]); b.z = cvt_pk_bf16(ub[0], ub[1]); b.w = cvt_pk_bf16(ub[2], ub[3]); *(u32x4*)(sp + 5632) = b; }
            }
    }
};
struct EpiResid {
    static constexpr bool PERM = true, AFTER_DRAIN = false;
    const float* xp; const float* xs; const bf16_t* XB; bf16_t* YB; const float* gate; float alpha;
    const float* stats; const float* lnw; const float* lnb;
    __device__ __forceinline__ void operator()(const f32x4 (&acc)[2][2][4][2], const Unit& u, int wr, int wc, int fr, int fq) const {
        const int modrow = u.pm < 16 ? 0 : 1 + ((u.pm - 16) >> 2);
        const float* g = gate + (size_t)modrow * 12288;
        const int row0 = u.pm * BM + wr * 64 + fr, col0 = u.pn * BM + wc * 32 + 8 * fq;
#pragma unroll
        for (int bj = 0; bj < 2; ++bj) {
            const int co = col0 + bj * HALF;
            const f32x4 gv0 = *(const f32x4*)(g + co), gv1 = *(const f32x4*)(g + co + 4);
            if (xp != nullptr) {
                f32x4 xa[3][2];
#define EPR_LOADF(slot, gidx) do { const int r_ = row0 + ((gidx) >> 2) * HALF + ((gidx) & 3) * 16; const float* xr_ = (r_ < 4096 ? xp + (size_t)r_ * 2048 : xs + (size_t)(r_ - 4096) * 2048) + co; \
                    xa[slot][0] = *(const f32x4*)(xr_); xa[slot][1] = *(const f32x4*)(xr_ + 4); } while (0)
                EPR_LOADF(0, 0); EPR_LOADF(1, 1);
#pragma unroll
                for (int gi = 0; gi < 8; ++gi) { const int ai = gi >> 2, m = gi & 3; const int r = row0 + ai * HALF + m * 16;
                    if (gi + 2 < 8) EPR_LOADF((gi + 2) % 3, gi + 2);
                    const f32x4 o0 = xa[gi % 3][0] * alpha + gv0 * acc[ai][bj][m][0], o1 = xa[gi % 3][1] * alpha + gv1 * acc[ai][bj][m][1];
                    u32x4 w; w.x = cvt_pk_bf16(o0[0], o0[1]); w.y = cvt_pk_bf16(o0[2], o0[3]); w.z = cvt_pk_bf16(o1[0], o1[1]); w.w = cvt_pk_bf16(o1[2], o1[3]);
                    *(u32x4*)(YB + (size_t)r * 2048 + co) = w;
                    asm volatile("" ::: "memory"); }
#undef EPR_LOADF
            } else {
                const f32x4 wv0 = *(const f32x4*)(lnw + co), wv1 = *(const f32x4*)(lnw + co + 4), bv0 = *(const f32x4*)(lnb + co), bv1 = *(const f32x4*)(lnb + co + 4);
                u32x4 xb[4]; f32x2 sb[4];
#define EPR_LOADB(slot, gidx) do { const int r_ = row0 + ((gidx) >> 2) * HALF + ((gidx) & 3) * 16; xb[slot] = *(const u32x4*)(XB + (size_t)r_ * 2048 + co); sb[slot] = *(const f32x2*)(stats + 2 * (size_t)r_); } while (0)
                EPR_LOADB(0, 0); EPR_LOADB(1, 1); EPR_LOADB(2, 2);
#pragma unroll
                for (int gi = 0; gi < 8; ++gi) { const int ai = gi >> 2, m = gi & 3; const int r = row0 + ai * HALF + m * 16;
                    if (gi + 3 < 8) EPR_LOADB((gi + 3) % 4, gi + 3);
                    const u32x4 xw = xb[gi % 4]; const f32x2 sc = sb[gi % 4];
                    f32x4 x0, x1; x0[0] = __uint_as_float(xw.x << 16); x0[1] = __uint_as_float(xw.x & 0xffff0000u); x0[2] = __uint_as_float(xw.y << 16); x0[3] = __uint_as_float(xw.y & 0xffff0000u);
                    x1[0] = __uint_as_float(xw.z << 16); x1[1] = __uint_as_float(xw.z & 0xffff0000u); x1[2] = __uint_as_float(xw.w << 16); x1[3] = __uint_as_float(xw.w & 0xffff0000u);
                    x0 = (x0 - sc[0]) * sc[1] * wv0 + bv0; x1 = (x1 - sc[0]) * sc[1] * wv1 + bv1;
                    const f32x4 o0 = x0 * alpha + gv0 * acc[ai][bj][m][0], o1 = x1 * alpha + gv1 * acc[ai][bj][m][1];
                    u32x4 w; w.x = cvt_pk_bf16(o0[0], o0[1]); w.y = cvt_pk_bf16(o0[2], o0[3]); w.z = cvt_pk_bf16(o1[0], o1[1]); w.w = cvt_pk_bf16(o1[2], o1[3]);
                    *(u32x4*)(YB + (size_t)r * 2048 + co) = w;
                    asm volatile("" ::: "memory"); }
#undef EPR_LOADB
            }
        }
    }
};
template <class Epi, class Sched, bool ALIGN_EPI = false, bool SP2 = false>
__device__ __forceinline__ void gemm_phase(PG8_LAS unsigned char* lds, const Gemm g, const Sched& S, const Epi& E) {
    const int tid = ::opaque_tid(), wid = __builtin_amdgcn_readfirstlane(tid >> 6), lane = tid & 63, wr = wid >> 2, wc = wid & 3, fr = lane & 15, fq = lane >> 4;
    const int K = g.K, nt = K / BK;
    unsigned voffA[2], voffB[2];
#pragma unroll
    for (int i = 0; i < 2; ++i) { int R, C; stage_rc(tid * 16 + i * 8192, R, C); const int Rb = Epi::PERM ? ((R & ~31) + perm32(R & 31)) : R;
        voffA[i] = (unsigned)(R * K + C) * 2u; voffB[i] = (unsigned)(Rb * K + C) * 2u; }
    const size_t kstep = (size_t)(BK * 2);
    const size_t hstep = (size_t)HALF * K * 2;
    const size_t tstep = 2 * hstep;
    const unsigned ldsw = (unsigned)wid * 1024u;
    const int aoff = lds_byte(wr * 64 + fr, fq * 8), boff = lds_byte(wc * 32 + fr, fq * 8);
#define PG8_SA(b, h) (((b) * 2 + (h)) * HTB)
#define PG8_SB(b, h) ((4 + (b) * 2 + (h)) * HTB)
#define PG8_STAGE(bufoff, gbase, voff) do { _Pragma("unroll") for (int _i = 0; _i < 2; ++_i) \
        __builtin_amdgcn_global_load_lds((const unsigned*)((const char*)(gbase) + (voff)[_i]), (PG8_LAS unsigned*)(lds + (bufoff) + ldsw + _i * 8192), 16, 0, 0); } while (0)
#define PG8_LDA(dst, b, h) do { _Pragma("unroll") for (int m = 0; m < 4; ++m) _Pragma("unroll") for (int k = 0; k < 2; ++k) dst[m][k] = *(const PG8_LAS bf16x8*)(lds + PG8_SA(b, h) + aoff + m * 2048 + k * 1024); } while (0)
#define PG8_LDB(dst, b, h) do { _Pragma("unroll") for (int n = 0; n < 2; ++n) _Pragma("unroll") for (int k = 0; k < 2; ++k) dst[n][k] = *(const PG8_LAS bf16x8*)(lds + PG8_SB(b, h) + boff + n * 2048 + k * 1024); } while (0)
#define PG8_MMA(ai, bj, At, Bt) do { __builtin_amdgcn_s_setprio(1); _Pragma("unroll") for (int m = 0; m < 4; ++m) _Pragma("unroll") for (int n = 0; n < 2; ++n) _Pragma("unroll") for (int k = 0; k < 2; ++k) \
        acc[ai][bj][m][n] = __builtin_amdgcn_mfma_f32_16x16x32_bf16(Bt[n][k], At[m][k], acc[ai][bj][m][n], 0, 0, 0); __builtin_amdgcn_s_setprio(0); } while (0)
#define PG8_WAIT_V(n) asm volatile("s_waitcnt vmcnt(" #n ")" ::: "memory")
#define PG8_WAIT_L(n) asm volatile("s_waitcnt lgkmcnt(" #n ")" ::: "memory")
#define PG8_BAR __builtin_amdgcn_s_barrier()
#define PG8_SCHED __builtin_amdgcn_sched_barrier(0)
    Unit cur, nxt; int ui = 0;
    if (!S.next(0, cur)) return;
    f32x4 acc[2][2][4][2];
#pragma unroll
    for (int a = 0; a < 2; ++a)
#pragma unroll
        for (int b = 0; b < 2; ++b)
#pragma unroll
            for (int m = 0; m < 4; ++m)
#pragma unroll
                for (int n = 0; n < 2; ++n) acc[a][b][m][n] = (f32x4){0.f, 0.f, 0.f, 0.f};
    bf16x8 At[4][2], B0[2][2], B1[2][2];
    const char* cA = (const char*)g.A + (size_t)cur.pm * tstep; const char* cB = (const char*)g.Bt + (size_t)cur.pn * tstep;
    S.a_ready(cur);
    if constexpr (SP2) {
        PG8_STAGE(PG8_SB(0, 0), cB, voffB); PG8_STAGE(PG8_SB(0, 1), cB + hstep, voffB); PG8_STAGE(PG8_SA(0, 0), cA, voffA); PG8_STAGE(PG8_SA(0, 1), cA + hstep, voffA);
        if (wr == 1) PG8_BAR;
        PG8_WAIT_V(2); PG8_BAR;
        PG8_STAGE(PG8_SB(1, 0), cB + kstep, voffB); PG8_STAGE(PG8_SA(1, 0), cA + kstep, voffA); PG8_STAGE(PG8_SB(1, 1), cB + hstep + kstep, voffB);
        PG8_WAIT_V(6); PG8_BAR;
    } else {
        PG8_STAGE(PG8_SB(0, 0), cB, voffB); PG8_STAGE(PG8_SA(0, 0), cA, voffA); PG8_STAGE(PG8_SB(0, 1), cB + hstep, voffB); PG8_STAGE(PG8_SA(0, 1), cA + hstep, voffA);
        if (wr == 1) PG8_BAR;
        PG8_WAIT_V(4); PG8_BAR;
        PG8_STAGE(PG8_SB(1, 0), cB + kstep, voffB); PG8_STAGE(PG8_SA(1, 0), cA + kstep, voffA); PG8_STAGE(PG8_SB(1, 1), cB + hstep + kstep, voffB);
        PG8_WAIT_V(6); PG8_BAR;
    }
    for (;;) {
        const bool has_next = S.next(ui + 1, nxt);
        const char* nA = has_next ? (const char*)g.A + (size_t)nxt.pm * tstep : cA; const char* nB = has_next ? (const char*)g.Bt + (size_t)nxt.pn * tstep : cB;
        for (int t = 0; t < nt; t += 2) {
            const bool last = (t == nt - 2);
            const char* a1 = cA + (size_t)(t + 1) * kstep;
            const char* a2 = last ? nA : cA + (size_t)(t + 2) * kstep; const char* b2 = last ? nB : cB + (size_t)(t + 2) * kstep;
            const char* a3 = a2 + kstep; const char* b3 = b2 + kstep;
            if (last && has_next) S.a_ready(nxt);
            if constexpr (SP2) {
            PG8_LDB(B0, 0, 0); PG8_LDB(B1, 0, 1); PG8_SCHED; PG8_LDA(At, 0, 0); PG8_STAGE(PG8_SA(1, 1), a1 + hstep, voffA);
            PG8_WAIT_V(8); PG8_WAIT_L(0); PG8_BAR; PG8_MMA(0, 0, At, B0); PG8_MMA(0, 1, At, B1); PG8_BAR; PG8_SCHED;
            PG8_LDA(At, 0, 1); PG8_STAGE(PG8_SB(0, 0), b2, voffB); PG8_STAGE(PG8_SB(0, 1), b2 + hstep, voffB); PG8_STAGE(PG8_SA(0, 0), a2, voffA);
            PG8_WAIT_V(8); PG8_WAIT_L(0); PG8_BAR; PG8_MMA(1, 0, At, B0); PG8_MMA(1, 1, At, B1); PG8_BAR; PG8_SCHED;
            PG8_LDB(B0, 1, 0); PG8_LDB(B1, 1, 1); PG8_SCHED; PG8_LDA(At, 1, 0); PG8_STAGE(PG8_SA(0, 1), a2 + hstep, voffA);
            PG8_WAIT_V(8); PG8_WAIT_L(0); PG8_BAR; PG8_MMA(0, 0, At, B0); PG8_MMA(0, 1, At, B1); PG8_BAR; PG8_SCHED;
            PG8_LDA(At, 1, 1); PG8_STAGE(PG8_SB(1, 0), b3, voffB); PG8_STAGE(PG8_SB(1, 1), b3 + hstep, voffB); PG8_STAGE(PG8_SA(1, 0), a3, voffA);
            PG8_WAIT_V(8); PG8_WAIT_L(0); PG8_BAR; PG8_MMA(1, 0, At, B0); PG8_MMA(1, 1, At, B1); PG8_BAR; PG8_SCHED;
            } else {
            PG8_LDB(B0, 0, 0); PG8_SCHED; PG8_LDA(At, 0, 0); PG8_STAGE(PG8_SA(1, 1), a1 + hstep, voffA);
            PG8_WAIT_L(8); PG8_BAR; PG8_WAIT_L(0); PG8_MMA(0, 0, At, B0); PG8_BAR; PG8_SCHED;
            PG8_LDB(B1, 0, 1); PG8_STAGE(PG8_SB(0, 0), b2, voffB);
            PG8_BAR; PG8_WAIT_L(0); PG8_MMA(0, 1, At, B1); PG8_BAR;
            PG8_LDA(At, 0, 1); PG8_STAGE(PG8_SA(0, 0), a2, voffA);
            PG8_BAR; PG8_WAIT_L(0); PG8_MMA(1, 0, At, B0); PG8_BAR; PG8_SCHED;
            PG8_STAGE(PG8_SB(0, 1), b2 + hstep, voffB);
            PG8_WAIT_V(6); PG8_BAR; PG8_MMA(1, 1, At, B1); PG8_BAR;
            PG8_LDB(B0, 1, 0); PG8_SCHED; PG8_LDA(At, 1, 0); PG8_STAGE(PG8_SA(0, 1), a2 + hstep, voffA);
            PG8_WAIT_L(8); PG8_BAR; PG8_WAIT_L(0); PG8_MMA(0, 0, At, B0); PG8_BAR; PG8_SCHED;
            PG8_LDB(B1, 1, 1); PG8_STAGE(PG8_SB(1, 0), b3, voffB);
            PG8_BAR; PG8_WAIT_L(0); PG8_MMA(0, 1, At, B1); PG8_BAR;
            PG8_LDA(At, 1, 1); PG8_STAGE(PG8_SA(1, 0), a3, voffA);
            PG8_BAR; PG8_WAIT_L(0); PG8_MMA(1, 0, At, B0); PG8_BAR; PG8_SCHED;
            PG8_STAGE(PG8_SB(1, 1), b3 + hstep, voffB);
            PG8_WAIT_V(6); PG8_BAR; PG8_MMA(1, 1, At, B1); PG8_BAR;
            }
        }
        if constexpr (ALIGN_EPI) { if (wr == 0) PG8_BAR; }
        if constexpr (!Epi::AFTER_DRAIN) { E(acc, cur, wr, wc, fr, fq); S.done(cur); }
        if (!has_next) break;
#pragma unroll
        for (int a = 0; a < 2; ++a)
#pragma unroll
            for (int b = 0; b < 2; ++b)
#pragma unroll
                for (int m = 0; m < 4; ++m)
#pragma unroll
                    for (int n = 0; n < 2; ++n) acc[a][b][m][n] = (f32x4){0.f, 0.f, 0.f, 0.f};
        cur = nxt; cA = nA; cB = nB; ++ui;
        if constexpr (ALIGN_EPI) { if (wr == 1) PG8_BAR; }
    }
    PG8_WAIT_V(0);
    if constexpr (!ALIGN_EPI) { if (wr == 0) PG8_BAR; }
    PG8_BAR;
    if constexpr (Epi::AFTER_DRAIN) { E.fused(acc, cur, wr, wc, fr, fq, lds, wid, lane); S.done(cur); }
#undef PG8_SA
#undef PG8_SB
#undef PG8_STAGE
#undef PG8_LDA
#undef PG8_LDB
#undef PG8_MMA
#undef PG8_WAIT_V
#undef PG8_WAIT_L
#undef PG8_BAR
#undef PG8_SCHED
}
}
namespace att {
using bf16 = unsigned short;
constexpr int   D = 128, NW = 8, QBLK = 32, KVBLK = 64;
constexpr float SCALE = 0.088388347648318440f;
constexpr float THR = 8.f;
constexpr int SDEPTH = 2;
constexpr size_t SHM_V = KVBLK * D * 2, SHM_K = KVBLK * D * 2, SHM_ATTN = 2 * SHM_V + 2 * SHM_K + NW * 64 * 4;
using bf16x8 = __attribute__((ext_vector_type(8))) short;
using s16x4  = __attribute__((ext_vector_type(4))) short;
using f32x16 = __attribute__((ext_vector_type(16))) float;
using f32x8  = __attribute__((ext_vector_type(8))) float;
using u32x4  = __attribute__((ext_vector_type(4))) unsigned;
#define KSWZ(row, colB) ((row) * 256 + ((colB) ^ (((row) & 7) << 4)))
#define SBAR() __builtin_amdgcn_sched_barrier(0)
__device__ __forceinline__ int crow(int r, int hi) { return (r & 3) + 8 * (r >> 2) + 4 * hi; }
__device__ __forceinline__ unsigned cvtpk(float lo, float hi) {
  unsigned r; asm volatile("v_cvt_pk_bf16_f32 %0, %1, %2" : "=v"(r) : "v"(lo), "v"(hi)); return r;
}
struct St { using T = bf16x8;
  __device__ static __forceinline__ T ld8(const bf16* p) { return *reinterpret_cast<const bf16x8*>(p); }
  __device__ static __forceinline__ bf16x8 tobf(T x) { return x; } };
__device__ __forceinline__ void partialSM(f32x16& p0, f32x16& p1, float& m_reg, float& mn, float& alpha) {
  constexpr float C = SCALE * 1.4426950408889634f;
  float pmax = p0[0]; for (int r = 1; r < 16; ++r) pmax = fmaxf(pmax, p0[r]); for (int r = 0; r < 16; ++r) pmax = fmaxf(pmax, p1[r]);
  { auto rr = __builtin_amdgcn_permlane32_swap(__float_as_uint(pmax), __float_as_uint(pmax), false, false);
    pmax = fmaxf(__uint_as_float(rr[0]), __uint_as_float(rr[1])); }
  if (__builtin_expect(__all(pmax - m_reg <= THR / SCALE), 1)) { mn = m_reg; alpha = 1.f; }
  else { mn = fmaxf(m_reg, pmax); alpha = __builtin_amdgcn_exp2f((m_reg - mn) * C); m_reg = mn; }
  float mnC = -mn * C;
  for (int r = 0; r < 16; ++r) p0[r] = fmaf(p0[r], C, mnC); for (int r = 0; r < 16; ++r) p1[r] = fmaf(p1[r], C, mnC);
  for (int r = 0; r < 16; ++r) p0[r] = __builtin_amdgcn_exp2f(p0[r]);
}
__device__ __forceinline__ void finishSM(f32x16& p0, f32x16& p1, float alpha, float& l_reg, bf16x8& pa0, bf16x8& pa1, bf16x8& pa2, bf16x8& pa3) {
  for (int r = 0; r < 16; ++r) p1[r] = __builtin_amdgcn_exp2f(p1[r]);
  float ps = 0; for (int r = 0; r < 16; ++r) ps += p0[r]; for (int r = 0; r < 16; ++r) ps += p1[r];
  { auto rr = __builtin_amdgcn_permlane32_swap(__float_as_uint(ps), __float_as_uint(ps), false, false);
    ps = __uint_as_float(rr[0]) + __uint_as_float(rr[1]); }
  l_reg = l_reg * alpha + ps;
#define PK4(P, BASE, OUT) do { unsigned a0 = cvtpk(P[BASE + 0], P[BASE + 1]), a1 = cvtpk(P[BASE + 2], P[BASE + 3]);   \
    unsigned b0 = cvtpk(P[BASE + 4], P[BASE + 5]), b1 = cvtpk(P[BASE + 6], P[BASE + 7]);                              \
    auto r0 = __builtin_amdgcn_permlane32_swap(a0, b0, false, false); auto r1 = __builtin_amdgcn_permlane32_swap(a1, b1, false, false); \
    u32x4 w = {r0[0], r1[0], r0[1], r1[1]}; OUT = *reinterpret_cast<bf16x8*>(&w); } while (0)
  PK4(p0, 0, pa0); PK4(p0, 8, pa1); PK4(p1, 0, pa2); PK4(p1, 8, pa3);
#undef PK4
}
__device__ __forceinline__ void qkt(f32x16& p0, f32x16& p1, const bf16* Ks, const bf16x8* qr, int r32, int hi) {
  p0 = f32x16{}; p1 = f32x16{};
  for (int d0 = 0; d0 < 8; ++d0) { int cb = (d0 * 16 + hi * 8) * 2;
    bf16x8 b0 = *reinterpret_cast<const bf16x8*>((const char*)Ks + KSWZ(r32, cb));
    bf16x8 b1 = *reinterpret_cast<const bf16x8*>((const char*)Ks + KSWZ(32 + r32, cb));
    p0 = __builtin_amdgcn_mfma_f32_32x32x16_bf16(b0, qr[d0], p0, 0, 0, 0);
    p1 = __builtin_amdgcn_mfma_f32_32x32x16_bf16(b1, qr[d0], p1, 0, 0, 0); }
}
__device__ __forceinline__ int v_st(int k, int c) { const int kk = (k & ~0xC) | ((k & 4) << 1) | ((k & 8) >> 1); return ((kk >> 3) * 4 + (c >> 5)) * 512 + ((kk & 7) * 32 + (c & 31)) * 2; }
__device__ __forceinline__ int v_rd_base(int lane) { return ((lane & 3) << 3) | (((lane >> 2) & 3) << 6) | (((lane >> 4) & 1) << 5) | (((lane >> 5) & 1) << 8); }
constexpr int v_rd_off(int d0, int ks, int half) { return d0 * 512 + ks * 4096 + half * 2048; }
template <int OFF> __device__ __forceinline__ s16x4 tr_read(int vb) {
  s16x4 r; asm volatile("ds_read_b64_tr_b16 %0, %1 offset:%2" : "=&v"(r) : "v"(vb), "i"(OFF) : "memory"); return r;
}
template <int D0> __device__ __forceinline__ void pv_one(f32x16& od, int vb, bf16x8 pa0, bf16x8 pa1, bf16x8 pa2, bf16x8 pa3) {
  const s16x4 l0 = tr_read<v_rd_off(D0, 0, 0)>(vb), h0 = tr_read<v_rd_off(D0, 0, 1)>(vb), l1 = tr_read<v_rd_off(D0, 1, 0)>(vb), h1 = tr_read<v_rd_off(D0, 1, 1)>(vb);
  const s16x4 l2 = tr_read<v_rd_off(D0, 2, 0)>(vb), h2 = tr_read<v_rd_off(D0, 2, 1)>(vb), l3 = tr_read<v_rd_off(D0, 3, 0)>(vb), h3 = tr_read<v_rd_off(D0, 3, 1)>(vb);
  asm volatile("s_waitcnt lgkmcnt(0)" ::: "memory"); SBAR();
#define PK(L, H) (bf16x8){L[0], L[1], L[2], L[3], H[0], H[1], H[2], H[3]}
  od = __builtin_amdgcn_mfma_f32_32x32x16_bf16(pa0, PK(l0, h0), od, 0, 0, 0);
  od = __builtin_amdgcn_mfma_f32_32x32x16_bf16(pa1, PK(l1, h1), od, 0, 0, 0);
  od = __builtin_amdgcn_mfma_f32_32x32x16_bf16(pa2, PK(l2, h2), od, 0, 0, 0);
  od = __builtin_amdgcn_mfma_f32_32x32x16_bf16(pa3, PK(l3, h3), od, 0, 0, 0);
#undef PK
}
__device__ __forceinline__ void pv_d0(f32x16* o, int vb, bf16x8 pa0, bf16x8 pa1, bf16x8 pa2, bf16x8 pa3) {
  pv_one<0>(o[0], vb, pa0, pa1, pa2, pa3); pv_one<1>(o[1], vb, pa0, pa1, pa2, pa3); pv_one<2>(o[2], vb, pa0, pa1, pa2, pa3); pv_one<3>(o[3], vb, pa0, pa1, pa2, pa3);
}
template <int LDQ, int LDK, int LDO>
__device__ __forceinline__ void attn_dense_body(const bf16* __restrict__ Qb, const bf16* __restrict__ Kh, const bf16* __restrict__ Vh,
                                                bf16* __restrict__ Ob, int seq, char* lds) {
  const int tid = ::opaque_tid(), wid = tid >> 6, lane = tid & 63, r32 = lane & 31, hi = lane >> 5;
  bf16* V_lds = (bf16*)lds; bf16* K_lds = (bf16*)(lds + 2 * SHM_V);
  float* ws = (float*)(lds + 2 * SHM_V + 2 * SHM_K) + wid * 64; float* li_l = ws; float* al_l = ws + 32;
  float m_reg = -1e30f, l_reg = 0; f32x16 o[4] = {}; bf16x8 qr[8];
  const bf16* Qw = Qb + (long)(wid * QBLK + r32) * LDQ + hi * 8;
#pragma unroll
  for (int d0 = 0; d0 < 8; ++d0) qr[d0] = St::ld8(Qw + d0 * 16);
  const int sr = tid >> 4, sc = (tid & 15) * 8, vst0 = v_st(sr, sc), vst1 = v_st(32 + sr, sc);
  const int vb0 = (int)(uintptr_t)V_lds + v_rd_base(lane);
  struct { typename St::T vs0, vs1, ks0, ks1; } sr_[1];
#define SLOAD(i, k0) do { sr_[i].vs0 = St::ld8(&Vh[(long)((k0) + sr) * LDK + sc]); sr_[i].vs1 = St::ld8(&Vh[(long)((k0) + 32 + sr) * LDK + sc]); \
    sr_[i].ks0 = St::ld8(&Kh[(long)((k0) + sr) * LDK + sc]); sr_[i].ks1 = St::ld8(&Kh[(long)((k0) + 32 + sr) * LDK + sc]); } while (0)
#define SWRITE(b, i) do { *(bf16x8*)((char*)V_lds + (b) * SHM_V + vst0) = St::tobf(sr_[i].vs0);          \
    *(bf16x8*)((char*)V_lds + (b) * SHM_V + vst1) = St::tobf(sr_[i].vs1); int kc = sc * 2;               \
    *(bf16x8*)((char*)K_lds + (b) * SHM_K + KSWZ(sr, kc)) = St::tobf(sr_[i].ks0);                       \
    *(bf16x8*)((char*)K_lds + (b) * SHM_K + KSWZ(32 + sr, kc)) = St::tobf(sr_[i].ks1); } while (0)
#define SWAIT() do { asm volatile("s_waitcnt vmcnt(0)" ::: "memory"); } while (0)
#define RESC(a) do { if (__any((a) < 1.f)) { if (hi == 0) al_l[r32] = (a); asm volatile("s_waitcnt lgkmcnt(0)" ::: "memory"); \
    for (int d = 0; d < 4; ++d) for (int r = 0; r < 16; ++r) o[d][r] *= al_l[crow(r, hi)]; } } while (0)
  f32x16 pA0, pA1, pB0, pB1; float mnA, mnB, alA, alB; bf16x8 pa0, pa1, pa2, pa3; const int NT = seq / KVBLK;
  constexpr int SE = 0, SO = 0;
  SLOAD(SE, 0); asm volatile("s_waitcnt vmcnt(0)" ::: "memory"); SWRITE(0, SE); __syncthreads();
  qkt(pA0, pA1, K_lds, qr, r32, hi); partialSM(pA0, pA1, m_reg, mnA, alA);
  SLOAD(SO, KVBLK);
  SWAIT(); SWRITE(1, SO); __syncthreads();
  for (int j = 1; j + 1 < NT; j += 2) {
    SBAR(); qkt(pB0, pB1, (bf16*)((char*)K_lds + SHM_K), qr, r32, hi);
    finishSM(pA0, pA1, alA, l_reg, pa0, pa1, pa2, pa3); SBAR();
    SLOAD(SO, (j + 1) * KVBLK); SBAR();
    pv_d0(o, vb0, pa0, pa1, pa2, pa3); partialSM(pB0, pB1, m_reg, mnB, alB);
    __syncthreads(); SWAIT(); SWRITE(0, SE);
    RESC(alB); __syncthreads();
    SBAR(); qkt(pA0, pA1, K_lds, qr, r32, hi);
    finishSM(pB0, pB1, alB, l_reg, pa0, pa1, pa2, pa3); SBAR();
    SLOAD(SE, (j + 2) * KVBLK); SBAR();
    pv_d0(o, vb0 + (int)SHM_V, pa0, pa1, pa2, pa3); partialSM(pA0, pA1, m_reg, mnA, alA);
    __syncthreads(); SWAIT(); SWRITE(1, SO);
    RESC(alA); __syncthreads();
  }
  SBAR(); qkt(pB0, pB1, (bf16*)((char*)K_lds + SHM_K), qr, r32, hi);
  finishSM(pA0, pA1, alA, l_reg, pa0, pa1, pa2, pa3); SBAR();
  pv_d0(o, vb0, pa0, pa1, pa2, pa3); partialSM(pB0, pB1, m_reg, mnB, alB);
  __syncthreads(); RESC(alB);
  finishSM(pB0, pB1, alB, l_reg, pa0, pa1, pa2, pa3); SBAR();
  pv_d0(o, vb0 + (int)SHM_V, pa0, pa1, pa2, pa3);
  if (hi == 0) li_l[r32] = l_reg; asm volatile("s_waitcnt lgkmcnt(0)" ::: "memory");
  float rli[16];
#pragma unroll
  for (int r = 0; r < 16; ++r) rli[r] = __builtin_amdgcn_rcpf(li_l[crow(r, hi)]);
  bf16* Ow = Ob + (long)(wid * QBLK) * LDO;
#pragma unroll
  for (int r = 0; r < 16; ++r) { int orow = crow(r, hi);
#pragma unroll
    for (int d0 = 0; d0 < 4; ++d0) Ow[(long)orow * LDO + d0 * 32 + r32] = (bf16)(cvtpk(o[d0][r] * rli[r], 0.f) & 0xffffu); }
  __syncthreads();
}

__device__ __forceinline__ void packP(const f32x16& p0, const f32x16& p1, bf16x8& pa0, bf16x8& pa1, bf16x8& pa2, bf16x8& pa3) {
#define PK4(P, BASE, OUT) do { unsigned a0 = cvtpk(P[BASE + 0], P[BASE + 1]), a1 = cvtpk(P[BASE + 2], P[BASE + 3]);   \
    unsigned b0 = cvtpk(P[BASE + 4], P[BASE + 5]), b1 = cvtpk(P[BASE + 6], P[BASE + 7]);                              \
    auto r0 = __builtin_amdgcn_permlane32_swap(a0, b0, false, false); auto r1 = __builtin_amdgcn_permlane32_swap(a1, b1, false, false); \
    u32x4 w = {r0[0], r1[0], r0[1], r1[1]}; OUT = *reinterpret_cast<bf16x8*>(&w); } while (0)
  PK4(p0, 0, pa0); PK4(p0, 8, pa1); PK4(p1, 0, pa2); PK4(p1, 8, pa3);
#undef PK4
}
template <int MODE>
__device__ __forceinline__ void ret_weight(f32x16& p0, f32x16& p1, int jt, int nst, int n, int L, float lgf, float lgb, int hi) {
  constexpr float LS = -3.5f;
  if (MODE == 0 && jt < nst) {
    const float w = (jt < 2) ? __builtin_amdgcn_exp2f(lgf * (float)(n + 1)) : __builtin_amdgcn_exp2f(lgb * (float)(L - n));
#pragma unroll
    for (int r = 0; r < 16; ++r) { p0[r] *= w; p1[r] *= w; }
  } else if (MODE == 0) {
    const float fd0 = (float)(n - (jt - nst) * 64 - 4 * hi);
    const float nlgb = -lgb;
#pragma unroll
    for (int r = 0; r < 16; ++r) {
#pragma unroll
      for (int half = 0; half < 2; ++half) {
        const float d = fd0 - (float)((r & 3) + 8 * (r >> 2) + 32 * half);
        float e = fminf(fmaf(lgf, d, LS), fmaf(nlgb, d, LS)); e = (d == 0.f) ? LS + 1.f : e;
        const float w = __builtin_amdgcn_exp2f(e);
        if (half == 0) p0[r] *= w; else p1[r] *= w;
      }
    }
  } else {
    const float fm0 = (float)(jt * 64 + 4 * hi); const bool bwd = n >= 128; const float c0 = bwd ? LS : fmaf(lgf, (float)(L - 1), LS), sl = bwd ? lgb : -lgf;
#pragma unroll
    for (int r = 0; r < 16; ++r) {
#pragma unroll
      for (int half = 0; half < 2; ++half) {
        const float m = fm0 + (float)((r & 3) + 8 * (r >> 2) + 32 * half);
        const float w = __builtin_amdgcn_exp2f(fmaf(sl, m, c0));
        if (half == 0) p0[r] *= w; else p1[r] *= w;
      }
    }
  }
}
#define SWAIT0() do { asm volatile("s_waitcnt vmcnt(0)" ::: "memory"); } while (0)
template <int MODE, int LDQ>
__device__ __forceinline__ void retn_body(const bf16* __restrict__ Qb, const bf16* __restrict__ Kh, const bf16* __restrict__ Vh, int seq, int nst, int nq0, int L,
                                          float lgf, float lgb, const bf16* __restrict__ Gb, bf16* __restrict__ Ob, float* __restrict__ So, char* lds) {
  constexpr int LDK = 128;
  const int tid = ::opaque_tid(), wid = tid >> 6, lane = tid & 63, r32 = lane & 31, hi = lane >> 5;
  bf16* V_lds = (bf16*)lds; bf16* K_lds = (bf16*)(lds + 2 * SHM_V);
  f32x16 o[4] = {}; bf16x8 qr[8];
  const bf16* Qw = Qb + (long)(wid * QBLK + r32) * LDQ + hi * 8;
#pragma unroll
  for (int d0 = 0; d0 < 8; ++d0) qr[d0] = St::ld8(Qw + d0 * 16);
  const int nq = nq0 + wid * QBLK + r32;
  const int sr = tid >> 4, sc = (tid & 15) * 8, vst0 = v_st(sr, sc), vst1 = v_st(32 + sr, sc);
  const int vb0 = (int)(uintptr_t)V_lds + v_rd_base(lane);
  struct { typename St::T vs0, vs1, ks0, ks1; } sr_[1];
  f32x16 pA0, pA1, pB0, pB1; bf16x8 pa0, pa1, pa2, pa3; const int NT = seq / KVBLK;
  constexpr int SE = 0, SO = 0;
  SLOAD(SE, 0); asm volatile("s_waitcnt vmcnt(0)" ::: "memory"); SWRITE(0, SE); __syncthreads();
  qkt(pA0, pA1, K_lds, qr, r32, hi); ret_weight<MODE>(pA0, pA1, 0, nst, nq, L, lgf, lgb, hi);
  SLOAD(SO, KVBLK);
  SWAIT0(); SWRITE(1, SO); __syncthreads();
  for (int j = 1; j + 1 < NT; j += 2) {
    SBAR(); qkt(pB0, pB1, (bf16*)((char*)K_lds + SHM_K), qr, r32, hi);
    packP(pA0, pA1, pa0, pa1, pa2, pa3); SBAR();
    SLOAD(SO, (j + 1) * KVBLK); SBAR();
    pv_d0(o, vb0, pa0, pa1, pa2, pa3); ret_weight<MODE>(pB0, pB1, j, nst, nq, L, lgf, lgb, hi);
    __syncthreads(); SWAIT0(); SWRITE(0, SE);
    __syncthreads();
    SBAR(); qkt(pA0, pA1, K_lds, qr, r32, hi);
    packP(pB0, pB1, pa0, pa1, pa2, pa3); SBAR();
    SLOAD(SE, (j + 2) * KVBLK); SBAR();
    pv_d0(o, vb0 + (int)SHM_V, pa0, pa1, pa2, pa3); ret_weight<MODE>(pA0, pA1, j + 1, nst, nq, L, lgf, lgb, hi);
    __syncthreads(); SWAIT0(); SWRITE(1, SO);
    __syncthreads();
  }
  SBAR(); qkt(pB0, pB1, (bf16*)((char*)K_lds + SHM_K), qr, r32, hi);
  packP(pA0, pA1, pa0, pa1, pa2, pa3); SBAR();
  pv_d0(o, vb0, pa0, pa1, pa2, pa3); ret_weight<MODE>(pB0, pB1, NT - 1, nst, nq, L, lgf, lgb, hi);
  __syncthreads();
  packP(pB0, pB1, pa0, pa1, pa2, pa3); SBAR();
  pv_d0(o, vb0 + (int)SHM_V, pa0, pa1, pa2, pa3);
  if (MODE == 1) {
#pragma unroll
    for (int r = 0; r < 16; ++r) { const int n = wid * QBLK + crow(r, hi); float* rowp = So + (size_t)(n >> 7) * 65536 + (size_t)(n & 127) * 128;
#pragma unroll
      for (int d0 = 0; d0 < 4; ++d0) rowp[d0 * 32 + r32] = o[d0][r]; }
  } else {
    bf16 graw[16][4];
#pragma unroll
    for (int r = 0; r < 16; ++r) { const int orow = wid * QBLK + crow(r, hi);
#pragma unroll
      for (int d0 = 0; d0 < 4; ++d0) graw[r][d0] = Gb[(long)orow * LDQ + d0 * 32 + r32]; }
#pragma unroll
    for (int r = 0; r < 16; ++r) { const int orow = wid * QBLK + crow(r, hi);
      float s = (o[0][r] + o[1][r]) + (o[2][r] + o[3][r]);
#pragma unroll
      for (int x = 1; x < 32; x <<= 1) s += __shfl_xor(s, x);
      const float mean = s * (1.f / 128.f);
      const float d0v = o[0][r] - mean, d1v = o[1][r] - mean, d2v = o[2][r] - mean, d3v = o[3][r] - mean;
      float q = (d0v * d0v + d1v * d1v) + (d2v * d2v + d3v * d3v);
#pragma unroll
      for (int x = 1; x < 32; x <<= 1) q += __shfl_xor(q, x);
      const float rstd = 1.0f / sqrtf(q * (1.f / 128.f) + 1e-6f);
      const float dv[4] = {d0v, d1v, d2v, d3v};
#pragma unroll
      for (int d0 = 0; d0 < 4; ++d0) { const float g = __uint_as_float(((unsigned)graw[r][d0]) << 16);
        const float sg = g * __builtin_amdgcn_rcpf(1.f + __expf(-g));
        Ob[(long)orow * 2048 + d0 * 32 + r32] = (bf16)(cvtpk(sg * dv[d0] * rstd, 0.f) & 0xffffu); }
    }
  }
  __syncthreads();
}
#undef SLOAD
#undef SWRITE
#undef SWAIT
#undef SWAIT0
#undef RESC
}
#define LAS __attribute__((address_space(3)))
typedef unsigned short bf16_t;
typedef float f32x4 __attribute__((ext_vector_type(4)));
typedef float f32x2 __attribute__((ext_vector_type(2)));
typedef unsigned u32x4 __attribute__((ext_vector_type(4)));
typedef unsigned u32x2 __attribute__((ext_vector_type(2)));
typedef short bf16x8 __attribute__((ext_vector_type(8)));
constexpr int DM = 2048, MROWS = 12288, MCTX = 4096, NIN = 5120, DFF = 5632, NUP = 11264;
constexpr size_t MiB = (size_t)1 << 20;
constexpr size_t WS_CTL = 0, WS_MOD = 1 * MiB, WS_GF0 = 2 * MiB, WS_GF1 = 3 * MiB, WS_IDQ = 7 * MiB;
constexpr size_t WS_WIN = 10 * MiB, WS_WOUT = 30 * MiB, WS_WUP = 38 * MiB, WS_WDN = 82 * MiB, WS_H = 104 * MiB, WS_OV = 152 * MiB;
constexpr size_t WS_PROJ = WS_OV, WS_CONCAT = WS_OV + 120 * MiB, WS_QN = WS_OV + 168 * MiB, WS_KBL = WS_OV + 192 * MiB, WS_VBL = WS_OV + 198 * MiB,
                 WS_KBC = WS_OV + 204 * MiB, WS_VBC = WS_OV + 206 * MiB, WS_KEL = WS_OV + 208 * MiB, WS_VEL = WS_OV + 218 * MiB, WS_KEC = WS_OV + 228 * MiB,
                 WS_VEC = WS_OV + 232 * MiB, WS_HYT = WS_OV + 236 * MiB;
constexpr size_t WS_STASH = WS_OV;
constexpr size_t WS_UP = WS_OV, WS_ACT = WS_OV + 264 * MiB, WS_W1SET = WS_OV + 396 * MiB, WS_YB = WS_W1SET + 94 * MiB, WS_END = WS_YB + 48 * MiB + 8 * MiB;
__device__ __forceinline__ size_t wofs(int l) { return l ? (WS_W1SET - WS_WIN) : 0; }
constexpr size_t WS_STATS1 = WS_CTL + 131072, WS_STATS2 = WS_CTL + 262144;
constexpr size_t GF_LSTRIDE = WS_YB + 48 * MiB - WS_GF0;
constexpr int LDS_BYTES = 147456, LDS_ITEM_OFF = LDS_BYTES - 64;
constexpr size_t OUT_CK = 25165824, OUT_CV = 27262976, OUT_ST = 29360128;

struct Params { const float* in[29]; float* out; unsigned char* ws; unsigned long long pad; };
typedef const __attribute__((address_space(4))) Params* KP;
__device__ __forceinline__ KP kp_fresh() { KP k = (KP)__builtin_amdgcn_kernarg_segment_ptr(); asm volatile("" : "+s"(k)); return k; }
enum { I_XP = 0, I_XS, I_CK, I_CV, I_ST, I_C, I_CCTX, I_WADA, I_BADA, I_WIN, I_QN, I_KN, I_RDEC, I_HYCONV, I_HW1, I_HB1, I_HFREQ, I_HW2, I_HB2, I_HW3, I_HYBIAS, I_WOUT,
       I_LN1W, I_LN1B, I_WUP, I_FFNCONV, I_WDN, I_LN2W, I_LN2B };

__device__ __forceinline__ unsigned f2bf(float f) { unsigned u = __builtin_bit_cast(unsigned, f); return (u + 0x7fffu + ((u >> 16) & 1u)) >> 16; }
__device__ __forceinline__ unsigned pk2(float lo, float hi) { return f2bf(lo) | (f2bf(hi) << 16); }
__device__ __forceinline__ float bf2f(unsigned short b) { return __uint_as_float(((unsigned)b) << 16); }
__device__ __forceinline__ float bflo(unsigned w) { return __uint_as_float(w << 16); }
__device__ __forceinline__ float bfhi(unsigned w) { return __uint_as_float(w & 0xffff0000u); }
__device__ __forceinline__ float wave_sum(float v) {
#pragma unroll
    for (int o = 1; o < 64; o <<= 1) v += __shfl_xor(v, o);
    return v;
}
__device__ __forceinline__ float silu_f(float x) { return x * __builtin_amdgcn_rcpf(1.f + __expf(-x)); }

__device__ __forceinline__ void transpose_tile(const float* __restrict__ W, int K, int N, bf16_t* __restrict__ WT, LAS float* scr, int tile, int lane) {
    const int nblk = N >> 6, kb = tile / nblk, nb = tile - kb * nblk, k0 = kb * 64, n0 = nb * 64;
    float v[64];
    const float* src = W + (size_t)k0 * N + n0 + lane;
#pragma unroll
    for (int i = 0; i < 64; ++i) v[i] = src[(size_t)i * N];
#pragma unroll
    for (int i = 0; i < 64; ++i) scr[i * 65 + lane] = v[i];
    asm volatile("s_waitcnt lgkmcnt(0)" ::: "memory");
    const int c = lane & 7;
#pragma unroll
    for (int j = 0; j < 8; ++j) { const int n = (lane >> 3) + 8 * j; const LAS float* s = scr + (8 * c) * 65 + n;
        u32x4 o; o.x = pk2(s[0 * 65], s[1 * 65]); o.y = pk2(s[2 * 65], s[3 * 65]); o.z = pk2(s[4 * 65], s[5 * 65]); o.w = pk2(s[6 * 65], s[7 * 65]);
        *(u32x4*)(WT + (size_t)(n0 + n) * K + k0 + 8 * c) = o; }
    asm volatile("s_waitcnt lgkmcnt(0)" ::: "memory");
}
__device__ __forceinline__ void transpose_tile_up(const float* __restrict__ W, bf16_t* __restrict__ WT, LAS float* scr, int tile, int lane) {
    constexpr int K = DM, N = NUP;
    const int nblk = N >> 6, kb = tile / nblk, nb = tile - kb * nblk, k0 = kb * 64, n0 = nb * 64;
    const int n0p = n0 < DFF ? 256 * (n0 >> 7) + (n0 & 127) : 256 * ((n0 - DFF) >> 7) + 128 + ((n0 - DFF) & 127);
    float v[64];
    const float* src = W + (size_t)k0 * N + n0 + lane;
#pragma unroll
    for (int i = 0; i < 64; ++i) v[i] = src[(size_t)i * N];
#pragma unroll
    for (int i = 0; i < 64; ++i) scr[i * 65 + lane] = v[i];
    asm volatile("s_waitcnt lgkmcnt(0)" ::: "memory");
    const int c = lane & 7;
#pragma unroll
    for (int j = 0; j < 8; ++j) { const int n = (lane >> 3) + 8 * j; const LAS float* s = scr + (8 * c) * 65 + n;
        u32x4 o; o.x = pk2(s[0 * 65], s[1 * 65]); o.y = pk2(s[2 * 65], s[3 * 65]); o.z = pk2(s[4 * 65], s[5 * 65]); o.w = pk2(s[6 * 65], s[7 * 65]);
        *(u32x4*)(WT + (size_t)(n0p + n) * K + k0 + 8 * c) = o; }
    asm volatile("s_waitcnt lgkmcnt(0)" ::: "memory");
}
constexpr int T_IN = 32 * 80, T_OUT = 32 * 32, T_UP = 32 * 176, T_DN = 88 * 32, T_ALL = T_IN + T_OUT + T_UP + T_DN;
__device__ __forceinline__ void convert_tile(KP p, LAS float* scr, int l, int it, int lane) {
    int r = it; const size_t wo = wofs(l);
    if (r < T_IN) { transpose_tile(p->in[I_WIN] + (size_t)l * DM * NIN, DM, NIN, (bf16_t*)(p->ws + WS_WIN + wo), scr, r, lane); return; } r -= T_IN;
    if (r < T_OUT) { transpose_tile(p->in[I_WOUT] + (size_t)l * DM * DM, DM, DM, (bf16_t*)(p->ws + WS_WOUT + wo), scr, r, lane); return; } r -= T_OUT;
    if (r < T_UP) { transpose_tile_up(p->in[I_WUP] + (size_t)l * DM * NUP, (bf16_t*)(p->ws + WS_WUP + wo), scr, r, lane); return; } r -= T_UP;
    if (r < T_DN) transpose_tile(p->in[I_WDN] + (size_t)l * DFF * DM, DFF, DM, (bf16_t*)(p->ws + WS_WDN + wo), scr, r, lane);
}
__device__ __forceinline__ void convert_weights(KP p, LAS unsigned char* lds, int l, int lo, int hi) {
    const int tid = opaque_tid(), wave = tid >> 6, lane = tid & 63;
    LAS float* scr = (LAS float*)lds + wave * (64 * 65);
    const int gw = blockIdx.x * 8 + wave, NGW = gridDim.x * 8;
    for (int it = lo + gw; it < hi; it += NGW) convert_tile(p, scr, l, it, lane);
}
__device__ __forceinline__ void convert_block_item(KP p, LAS unsigned char* lds, int l, int tile0) {
    const int tid = opaque_tid(), wave = tid >> 6, lane = tid & 63;
    convert_tile(p, (LAS float*)lds + wave * (64 * 65), l, tile0 + wave, lane);
}
__device__ __forceinline__ void adaln_item(KP p, LAS unsigned char* lds, int item) {
    LAS float* scond = (LAS float*)lds;
    LAS float* red = (LAS float*)(lds + 98304);
    const int tid = opaque_tid(), w = tid >> 6, lane = tid & 63;
    { float cv[4][9];
#pragma unroll
      for (int kk = 0; kk < 4; ++kk) { const int k = tid + 512 * kk; cv[kk][0] = p->in[I_CCTX][k];
#pragma unroll
          for (int r = 1; r < 9; ++r) cv[kk][r] = p->in[I_C][(r - 1) * 2048 + k]; }
#pragma unroll
      for (int kk = 0; kk < 4; ++kk) { const int k = tid + 512 * kk;
#pragma unroll
          for (int r = 0; r < 9; ++r) scond[k * 12 + r] = silu_f(cv[kk][r]); } }
    __syncthreads();
    float* mod = (float*)(p->ws + WS_MOD);
    {
        const int l = item / 96, jj = item - l * 96, j = jj >> 1, kh = jj & 1;
        const float* W = p->in[I_WADA] + (size_t)l * 2048 * 12288 + j * 256 + lane * 4;
        f32x4 acc[9];
#pragma unroll
        for (int r = 0; r < 9; ++r) acc[r] = (f32x4){0.f, 0.f, 0.f, 0.f};
        const int k0 = kh * 1024 + w * 128;
#pragma unroll 8
        for (int k = k0; k < k0 + 128; ++k) {
            const f32x4 wv = *(const f32x4*)(W + (size_t)k * 12288);
            const f32x4 s0 = *(const LAS f32x4*)(scond + k * 12), s1 = *(const LAS f32x4*)(scond + k * 12 + 4), s2 = *(const LAS f32x4*)(scond + k * 12 + 8);
            acc[0] += wv * s0[0]; acc[1] += wv * s0[1]; acc[2] += wv * s0[2]; acc[3] += wv * s0[3];
            acc[4] += wv * s1[0]; acc[5] += wv * s1[1]; acc[6] += wv * s1[2]; acc[7] += wv * s1[3]; acc[8] += wv * s2[0];
        }
#pragma unroll
        for (int half = 0; half < 2; ++half) {
            __syncthreads();
#pragma unroll
            for (int q = 0; q < 18; ++q) { const int qq = half * 18 + q; red[(w * 18 + q) * 64 + lane] = acc[qq >> 2][qq & 3]; }
            __syncthreads();
            for (int idx = tid; idx < 18 * 64; idx += 512) { const int q = idx >> 6, ln = idx & 63; float s = 0.f;
#pragma unroll
                for (int ww = 0; ww < 8; ++ww) s += red[(ww * 18 + q) * 64 + ln];
                const int qq = half * 18 + q, r = qq >> 2, col = j * 256 + ln * 4 + (qq & 3);
                if (kh == 0) s += p->in[I_BADA][l * 12288 + col];
                atomicAdd(mod + (size_t)(l * 9 + r) * 12288 + col, s); }
        }
        __syncthreads();
    }
}
__device__ __forceinline__ void filter_items(KP p, LAS unsigned char* lds, int l, int item_lo, int item_hi, int item_step) {
    LAS float* zb = (LAS float*)lds;
    LAS float* h1 = zb + 8 * 36;
    LAS float* h2 = h1 + 8 * 64;
    LAS float* W1s = h2 + 8 * 64;
    LAS float* W2s = W1s + 33 * 64;
    const int tid = opaque_tid();
    const float* w1 = p->in[I_HW1] + l * 33 * 64; const float* b1 = p->in[I_HB1] + l * 64; const float* fr = p->in[I_HFREQ] + l * 64;
    const float* w2 = p->in[I_HW2] + l * 64 * 64; const float* b2 = p->in[I_HB2] + l * 64; const float* w3 = p->in[I_HW3] + (size_t)l * 64 * 2048;
    { float t1[5], t2[8];
#pragma unroll
      for (int k = 0; k < 5; ++k) t1[k] = (tid + 512 * k < 33 * 64) ? w1[tid + 512 * k] : 0.f;
#pragma unroll
      for (int k = 0; k < 8; ++k) t2[k] = w2[tid + 512 * k];
#pragma unroll
      for (int k = 0; k < 5; ++k) if (tid + 512 * k < 33 * 64) W1s[tid + 512 * k] = t1[k];
#pragma unroll
      for (int k = 0; k < 8; ++k) W2s[tid + 512 * k] = t2[k]; }
    __syncthreads();
    for (int item = item_lo; item < item_hi; item += item_step) {
        const int g = item < 32 ? 0 : 1, tb = g ? item - 32 : item, L = g ? 1024 : 256;
        bf16_t* GF = (bf16_t*)(p->ws + (g ? WS_GF1 : WS_GF0) + (size_t)l * GF_LSTRIDE);
        if (tid < 8 * 33) { const int tl = tid / 33, i = tid - tl * 33; const int t = tb * 8 + tl; float z;
            if (i == 0) z = (float)t / (float)(L - 1);
            else { const int fi = (i - 1) & 15; const float f = 1e-4f + (float)fi * ((15.0f - 1e-4f) / 15.0f); const float ang = (6.283185307179586f * (float)t / (float)L) * f;
                z = (i <= 16) ? cosf(ang) : -sinf(ang); }
            zb[tl * 36 + i] = z; }
        __syncthreads();
        { const int tl = tid >> 6, j = tid & 63; float s = b1[j];
#pragma unroll 11
          for (int i = 0; i < 33; ++i) s += zb[tl * 36 + i] * W1s[i * 64 + j];
          h1[tl * 64 + j] = sinf(fr[j] * s); }
        __syncthreads();
        { const int tl = tid >> 6, j = tid & 63; float s = b2[j];
#pragma unroll 8
          for (int i = 0; i < 64; ++i) s += h1[tl * 64 + i] * W2s[i * 64 + j];
          h2[tl * 64 + j] = sinf(fr[j] * s); }
        __syncthreads();
        { const int q0 = tid * 4; const int o = q0 >> 10, dir = (q0 >> 9) & 1, c0 = q0 & 511;
            f32x4 acc[8];
#pragma unroll
            for (int tl = 0; tl < 8; ++tl) acc[tl] = (f32x4){0.f, 0.f, 0.f, 0.f};
#pragma unroll 1
            for (int i0 = 0; i0 < 64; i0 += 16) { f32x4 wv[16];
#pragma unroll
                for (int ii = 0; ii < 16; ++ii) wv[ii] = *(const f32x4*)(w3 + (size_t)(i0 + ii) * 2048 + q0);
#pragma unroll
                for (int ii = 0; ii < 16; ++ii)
#pragma unroll
                    for (int tl = 0; tl < 8; ++tl) acc[tl] += wv[ii] * h2[tl * 64 + i0 + ii]; }
            const float a = -15.350567286626973f, b = -3.0701134573253945f;
#pragma unroll
            for (int e = 0; e < 4; ++e) { const int c = c0 + e; const float delta = fabsf(a + (float)c * ((b - a) / 511.0f));
                bf16_t* Gc = GF + ((size_t)o * 512 + c) * (2 * L);
#pragma unroll
                for (int tl = 0; tl < 8; ++tl) { const int t = tb * 8 + tl; const float tt = (float)t / (float)(L - 1); const float val = acc[tl][e] * __expf(-tt * delta);
                    const int y = dir ? L + t + 1 : L - t; if (y < 2 * L) Gc[y] = (bf16_t)f2bf(val); }
                if (tb == 0 && dir == 0) Gc[0] = 0; }
        }
        __syncthreads();
    }
}
__device__ __forceinline__ int mod_row(int r) { return r < MCTX ? 0 : 1 + ((r - MCTX) >> 10); }
__device__ __forceinline__ void mod0_phase(KP p) {
    const int tid = opaque_tid(), wave = tid >> 6, lane = tid & 63, gw = blockIdx.x * 8 + wave, NGW = gridDim.x * 8;
    const float* mod = (const float*)(p->ws + WS_MOD); bf16_t* H = (bf16_t*)(p->ws + WS_H);
#pragma unroll 1
    for (int r = gw; r < MROWS; r += NGW) {
        const float* x = r < MCTX ? p->in[I_XP] + (size_t)r * DM : p->in[I_XS] + (size_t)(r - MCTX) * DM;
        const float* mr = mod + (size_t)mod_row(r) * 12288;
        f32x4 xv[8], shv[8], scv[8];
#pragma unroll
        for (int j = 0; j < 8; ++j) { const int c = (lane + 64 * j) * 4; xv[j] = *(const f32x4*)(x + c); shv[j] = *(const f32x4*)(mr + c); scv[j] = *(const f32x4*)(mr + 2048 + c); }
#pragma unroll
        for (int j = 0; j < 8; ++j) { const int c = (lane + 64 * j) * 4;
            const f32x4 h = xv[j] * (scv[j] + 1.0f) + shv[j]; u32x2 o; o.x = pk2(h[0], h[1]); o.y = pk2(h[2], h[3]); *(u32x2*)(H + (size_t)r * DM + c) = o; }
    }
}
__device__ __forceinline__ void ln_phase(KP p, const float* lw, const float* lb, const float* mod_next, float* stats_out, float* Yout) {
    const int tid = opaque_tid(), wave = tid >> 6, lane = tid & 63, gw = blockIdx.x * 8 + wave, NGW = gridDim.x * 8;
    const bf16_t* YB = (const bf16_t*)(p->ws + WS_YB); bf16_t* H = (bf16_t*)(p->ws + WS_H);
    f32x4 wreg[8], breg[8];
#pragma unroll
    for (int j = 0; j < 4; ++j) { const int c = (lane + 64 * j) * 8; wreg[2 * j] = *(const f32x4*)(lw + c); wreg[2 * j + 1] = *(const f32x4*)(lw + c + 4); breg[2 * j] = *(const f32x4*)(lb + c); breg[2 * j + 1] = *(const f32x4*)(lb + c + 4); }
    u32x4 nx[4];
    if (gw < MROWS) {
#pragma unroll
        for (int j = 0; j < 4; ++j) nx[j] = *(const u32x4*)(YB + (size_t)gw * DM + (lane + 64 * j) * 8); }
#pragma unroll 1
    for (int r = gw; r < MROWS; r += NGW) {
        f32x4 v[8]; float s = 0.f;
#pragma unroll
        for (int j = 0; j < 4; ++j) { const u32x4 xw = nx[j];
            v[2 * j][0] = bflo(xw.x); v[2 * j][1] = bfhi(xw.x); v[2 * j][2] = bflo(xw.y); v[2 * j][3] = bfhi(xw.y);
            v[2 * j + 1][0] = bflo(xw.z); v[2 * j + 1][1] = bfhi(xw.z); v[2 * j + 1][2] = bflo(xw.w); v[2 * j + 1][3] = bfhi(xw.w); }
#pragma unroll
        for (int j = 0; j < 8; ++j) s += (v[j][0] + v[j][1]) + (v[j][2] + v[j][3]);
        if (r + NGW < MROWS) {
#pragma unroll
            for (int j = 0; j < 4; ++j) nx[j] = *(const u32x4*)(YB + (size_t)(r + NGW) * DM + (lane + 64 * j) * 8); }
        const float mean = wave_sum(s) * (1.f / DM); float q = 0.f;
#pragma unroll
        for (int j = 0; j < 8; ++j) { v[j] = v[j] - mean; q += (v[j][0] * v[j][0] + v[j][1] * v[j][1]) + (v[j][2] * v[j][2] + v[j][3] * v[j][3]); }
        const float rstd = 1.0f / sqrtf(wave_sum(q) * (1.f / DM) + 1e-6f);
        const float* mr = mod_next ? mod_next + (size_t)mod_row(r) * 12288 : nullptr;
        if (stats_out && lane == 0) { stats_out[2 * (size_t)r] = mean; stats_out[2 * (size_t)r + 1] = rstd; }
        f32x4 shv[8], scv[8];
        if (mod_next) {
#pragma unroll
            for (int j = 0; j < 4; ++j) { const int c = (lane + 64 * j) * 8; shv[2 * j] = *(const f32x4*)(mr + c); shv[2 * j + 1] = *(const f32x4*)(mr + c + 4); scv[2 * j] = *(const f32x4*)(mr + 2048 + c); scv[2 * j + 1] = *(const f32x4*)(mr + 2048 + c + 4); } }
#pragma unroll
        for (int j = 0; j < 4; ++j) { const int c = (lane + 64 * j) * 8;
            const f32x4 o0 = v[2 * j] * rstd * wreg[2 * j] + breg[2 * j], o1 = v[2 * j + 1] * rstd * wreg[2 * j + 1] + breg[2 * j + 1];
            if (Yout) { *(f32x4*)(Yout + (size_t)r * DM + c) = o0; *(f32x4*)(Yout + (size_t)r * DM + c + 4) = o1; }
            if (mod_next) { const f32x4 h0 = o0 * (scv[2 * j] + 1.0f) + shv[2 * j], h1 = o1 * (scv[2 * j + 1] + 1.0f) + shv[2 * j + 1];
                u32x4 ob; ob.x = pk2(h0[0], h0[1]); ob.y = pk2(h0[2], h0[3]); ob.z = pk2(h1[0], h1[1]); ob.w = pk2(h1[2], h1[3]); *(u32x4*)(H + (size_t)r * DM + c) = ob; } }
    }
}
__device__ __forceinline__ void unpack8(const u32x4 a, float* d) { d[0] = bflo(a.x); d[1] = bfhi(a.x); d[2] = bflo(a.y); d[3] = bfhi(a.y); d[4] = bflo(a.z); d[5] = bfhi(a.z); d[6] = bflo(a.w); d[7] = bfhi(a.w); }
__device__ __forceinline__ void gate_phase(KP p, int l) {
    const bf16_t* __restrict__ UP = (const bf16_t*)(p->ws + WS_UP); bf16_t* __restrict__ ACT = (bf16_t*)(p->ws + WS_ACT);
    const float* cw = p->in[I_FFNCONV] + (size_t)l * 3 * NUP;
    const int gt = blockIdx.x * 512 + opaque_tid(), GT = gridDim.x * 512;
    for (int u = gt; u < 704 * 384; u += GT) {
        const int rs = u / 704, cg = u - rs * 704, c0 = cg * 8, r0 = rs * 32;
        const int Lseq = r0 < MCTX ? 256 : 1024; const int t0 = (r0 < MCTX ? r0 : r0 - MCTX) & (Lseq - 1);
        float wg[3][8], wu[3][8];
#pragma unroll
        for (int k = 0; k < 3; ++k) { const f32x4 a0 = *(const f32x4*)(cw + k * NUP + c0), a1 = *(const f32x4*)(cw + k * NUP + c0 + 4), b0 = *(const f32x4*)(cw + k * NUP + DFF + c0), b1 = *(const f32x4*)(cw + k * NUP + DFF + c0 + 4);
#pragma unroll
            for (int e = 0; e < 4; ++e) { wg[k][e] = a0[e]; wg[k][4 + e] = a1[e]; wu[k][e] = b0[e]; wu[k][4 + e] = b1[e]; } }
        float gp[8], gc[8], gn[8], up_[8], uc[8], un[8];
        const u32x4 zero4 = (u32x4){0u, 0u, 0u, 0u};
        const bf16_t* base = UP + (size_t)r0 * NUP + c0;
        { const u32x4 a = t0 > 0 ? *(const u32x4*)(base - NUP) : zero4, b2 = t0 > 0 ? *(const u32x4*)(base - NUP + DFF) : zero4; unpack8(a, gp); unpack8(b2, up_);
          const u32x4 c = *(const u32x4*)base, d = *(const u32x4*)(base + DFF); unpack8(c, gc); unpack8(d, uc); }
        u32x4 ng[4], nu[4];
#pragma unroll
        for (int k = 0; k < 4; ++k) { const bool valid = t0 + k + 1 < Lseq; const bf16_t* s = base + (size_t)(k + 1) * NUP;
            ng[k] = valid ? *(const u32x4*)s : zero4; nu[k] = valid ? *(const u32x4*)(s + DFF) : zero4; }
#pragma unroll 1
        for (int i0 = 0; i0 < 32; i0 += 4) {
            u32x4 rg[4], ru[4];
#pragma unroll
            for (int k = 0; k < 4; ++k) { rg[k] = ng[k]; ru[k] = nu[k]; }
            if (i0 + 4 < 32) {
#pragma unroll
                for (int k = 0; k < 4; ++k) { const bool valid = t0 + i0 + 4 + k + 1 < Lseq; const bf16_t* s = base + (size_t)(i0 + 4 + k + 1) * NUP;
                    ng[k] = valid ? *(const u32x4*)s : zero4; nu[k] = valid ? *(const u32x4*)(s + DFF) : zero4; } }
#pragma unroll
            for (int k = 0; k < 4; ++k) { unpack8(rg[k], gn); unpack8(ru[k], un);
                float o[8];
#pragma unroll
                for (int e = 0; e < 8; ++e) { const float G = wg[0][e] * gp[e] + wg[1][e] * gc[e] + wg[2][e] * gn[e], U = wu[0][e] * up_[e] + wu[1][e] * uc[e] + wu[2][e] * un[e];
                    o[e] = silu_f(G) * U; gp[e] = gc[e]; gc[e] = gn[e]; up_[e] = uc[e]; uc[e] = un[e]; }
                u32x4 w; w.x = pk2(o[0], o[1]); w.y = pk2(o[2], o[3]); w.z = pk2(o[4], o[5]); w.w = pk2(o[6], o[7]);
                *(u32x4*)(ACT + (size_t)(r0 + i0 + k) * DFF + c0) = w; }
        }
    }
}
__device__ __forceinline__ void gate_fixup_phase(KP p, int l) {
    const bf16_t* __restrict__ ST = (const bf16_t*)(p->ws + WS_STASH); bf16_t* __restrict__ ACT = (bf16_t*)(p->ws + WS_ACT);
    const float* cw = p->in[I_FFNCONV] + (size_t)l * 3 * NUP;
    const int gt = blockIdx.x * 512 + opaque_tid(), GT = gridDim.x * 512;
    for (int u = gt; u < 384 * 704; u += GT) {
        const int br = u / 704, cg = u - br * 704, c0 = cg * 8, grp = br >> 1, which = br & 1, r = grp * 64 + (which ? 63 : 0);
        const int Lseq = r < MCTX ? 256 : 1024; const int t = (r < MCTX ? r : r - MCTX) & (Lseq - 1);
        const u32x4 zero4 = (u32x4){0u, 0u, 0u, 0u};
        const bf16_t* sp; const bf16_t* sc; const bf16_t* sn; bool vp, vn;
        if (which == 0) { sc = ST + (size_t)((grp * 4 + 0) * 2) * DFF; sn = ST + (size_t)((grp * 4 + 1) * 2) * DFF; sp = ST + (size_t)(((grp - 1) * 4 + 3) * 2) * DFF; vp = t > 0; vn = true; }
        else { sc = ST + (size_t)((grp * 4 + 3) * 2) * DFF; sp = ST + (size_t)((grp * 4 + 2) * 2) * DFF; sn = ST + (size_t)(((grp + 1) * 4 + 0) * 2) * DFF; vp = true; vn = t < Lseq - 1; }
        float gp[8], gc[8], gn[8], up_[8], uc[8], un[8];
        unpack8(vp ? *(const u32x4*)(sp + c0) : zero4, gp); unpack8(vp ? *(const u32x4*)(sp + DFF + c0) : zero4, up_);
        unpack8(*(const u32x4*)(sc + c0), gc); unpack8(*(const u32x4*)(sc + DFF + c0), uc);
        unpack8(vn ? *(const u32x4*)(sn + c0) : zero4, gn); unpack8(vn ? *(const u32x4*)(sn + DFF + c0) : zero4, un);
        float o[8];
#pragma unroll
        for (int e = 0; e < 8; ++e) { const float G = cw[c0 + e] * gp[e] + cw[NUP + c0 + e] * gc[e] + cw[2 * NUP + c0 + e] * gn[e];
            const float U = cw[DFF + c0 + e] * up_[e] + cw[NUP + DFF + c0 + e] * uc[e] + cw[2 * NUP + DFF + c0 + e] * un[e]; o[e] = silu_f(G) * U; }
        u32x4 w; w.x = pk2(o[0], o[1]); w.y = pk2(o[2], o[3]); w.z = pk2(o[4], o[5]); w.w = pk2(o[6], o[7]);
        *(u32x4*)(ACT + (size_t)r * DFF + c0) = w;
    }
}
__device__ __forceinline__ void prep_phase(KP p, int l) {
    const int tid = opaque_tid(), wave = tid >> 6, lane = tid & 63, gw = blockIdx.x * 8 + wave, NGW = gridDim.x * 8;
    const int gt = blockIdx.x * 512 + tid, GT = gridDim.x * 512;
    const bf16_t* PROJ = (const bf16_t*)(p->ws + WS_PROJ);
    bf16_t* QN = (bf16_t*)(p->ws + WS_QN); bf16_t* KBL = (bf16_t*)(p->ws + WS_KBL); bf16_t* VBL = (bf16_t*)(p->ws + WS_VBL); bf16_t* KBC = (bf16_t*)(p->ws + WS_KBC); bf16_t* VBC = (bf16_t*)(p->ws + WS_VBC);
    const float* qnw = p->in[I_QN] + l * 128; const float* knw = p->in[I_KN] + l * 128;
    const float invf = exp2f(-(float)(lane & 31) * (13.287712379549449f / 32.0f));
    const float qw0 = qnw[lane], qw1 = qnw[lane + 64], kw0 = knw[lane], kw1 = knw[lane + 64];
    bf16_t n0[12], n1[12];
    if (gw < MROWS) {
#pragma unroll
        for (int hh = 0; hh < 12; ++hh) { n0[hh] = PROJ[(size_t)gw * NIN + hh * 128 + lane]; n1[hh] = PROJ[(size_t)gw * NIN + hh * 128 + 64 + lane]; } }
#pragma unroll 1
    for (int r = gw; r < MROWS; r += NGW) {
        const bf16_t* src = PROJ + (size_t)r * NIN;
        bf16_t a0[12], a1[12];
#pragma unroll
        for (int hh = 0; hh < 12; ++hh) { a0[hh] = n0[hh]; a1[hh] = n1[hh]; }
        if (r + NGW < MROWS) {
#pragma unroll
            for (int hh = 0; hh < 12; ++hh) { n0[hh] = src[(size_t)NGW * NIN + hh * 128 + lane]; n1[hh] = src[(size_t)NGW * NIN + hh * 128 + 64 + lane]; } }
        const bool lat = r >= MCTX; const int rl = lat ? r - MCTX : r; const int b = lat ? rl >> 10 : rl >> 8; const int t = lat ? rl & 1023 : rl & 255;
        float cs = 1.f, sn = 0.f;
        if (lat) { const float pos = (lane < 32) ? (float)(t >> 6) : (float)(t & 63); const float ang = pos * invf; cs = cosf(ang); sn = sinf(ang); }
#pragma unroll
        for (int hh = 0; hh < 10; ++hh) {
            const float v0 = bf2f(a0[hh]), v1 = bf2f(a1[hh]);
            const float ss = wave_sum(v0 * v0 + v1 * v1); const float rinv = 1.0f / sqrtf(ss * (1.f / 128.f) + 1e-6f);
            const float y0 = v0 * rinv * (hh < 8 ? qw0 : kw0), y1 = v1 * rinv * (hh < 8 ? qw1 : kw1);
            const float o0 = y0 * cs - y1 * sn, o1 = y0 * sn + y1 * cs;
            if (hh < 8) { bf16_t* d = QN + (size_t)r * 1024 + hh * 128; d[lane] = (bf16_t)f2bf(o0); d[lane + 64] = (bf16_t)f2bf(o1); }
            else { const int kvh = hh - 8;
                if (lat) { bf16_t* dk = KBL + ((size_t)(b * 2 + kvh) * 1536 + 512 + t) * 128; bf16_t* dv = VBL + ((size_t)(b * 2 + kvh) * 1536 + 512 + t) * 128;
                    dk[lane] = (bf16_t)f2bf(o0); dk[lane + 64] = (bf16_t)f2bf(o1); dv[lane] = a0[hh + 2]; dv[lane + 64] = a1[hh + 2]; }
                else { bf16_t* dk = KBC + ((size_t)(b * 2 + kvh) * 256 + t) * 128; bf16_t* dv = VBC + ((size_t)(b * 2 + kvh) * 256 + t) * 128;
                    dk[lane] = (bf16_t)f2bf(y0); dk[lane + 64] = (bf16_t)f2bf(y1); dv[lane] = a0[hh + 2]; dv[lane + 64] = a1[hh + 2];
                    float* ck = p->out + OUT_CK + ((size_t)((b * 2 + l) * 2 + kvh) * 256 + t) * 128; float* cv = p->out + OUT_CV + ((size_t)((b * 2 + l) * 2 + kvh) * 256 + t) * 128;
                    ck[lane] = y0; ck[lane + 64] = y1; cv[lane] = bf2f(a0[hh + 2]); cv[lane + 64] = bf2f(a1[hh + 2]); } }
        }
    }
    for (int u = gt; u < 8 * 2 * 512 * 16 * 2; u += GT) {
        const int kv = u & 1, e = u >> 1; const int cgp = e & 15, j = (e >> 4) & 511, kvh = (e >> 13) & 1, b = e >> 14;
        const float* src = p->in[kv ? I_CV : I_CK] + ((size_t)((b * 2 + l) * 2 + kvh) * 512 + j) * 128 + cgp * 8;
        const f32x4 a = *(const f32x4*)src, c = *(const f32x4*)(src + 4);
        u32x4 o; o.x = pk2(a[0], a[1]); o.y = pk2(a[2], a[3]); o.z = pk2(c[0], c[1]); o.w = pk2(c[2], c[3]);
        *(u32x4*)((kv ? VBL : KBL) + ((size_t)(b * 2 + kvh) * 1536 + j) * 128 + cgp * 8) = o;
    }
    bf16_t* KEL = (bf16_t*)(p->ws + WS_KEL); bf16_t* VEL = (bf16_t*)(p->ws + WS_VEL); bf16_t* KEC = (bf16_t*)(p->ws + WS_KEC); bf16_t* VEC = (bf16_t*)(p->ws + WS_VEC);
    for (int u = gt; u < 8 * 4 * 1280 * 16; u += GT) {
        const int cgp = u & 15; const int e = u >> 4; const int i = e % 1280, bh = e / 1280, h = bh & 3, b = bh >> 2;
        u32x4 ko, vo;
        if (i < 256) { const int dd = i & 127; ko = (u32x4){0u, 0u, 0u, 0u};
            if ((dd >> 3) == cgp) { const unsigned one = (dd & 1) ? 0x3F800000u : 0x00003F80u; const int wsel = (dd & 7) >> 1; ko.x = wsel == 0 ? one : 0u; ko.y = wsel == 1 ? one : 0u; ko.z = wsel == 2 ? one : 0u; ko.w = wsel == 3 ? one : 0u; }
            const float* st = p->in[I_ST] + ((size_t)(((b * 2 + l) * 2 + (i >> 7)) * 4 + h) * 128 + dd) * 128 + cgp * 8;
            const f32x4 a = *(const f32x4*)st, c = *(const f32x4*)(st + 4);
            vo.x = pk2(a[0], a[1]); vo.y = pk2(a[2], a[3]); vo.z = pk2(c[0], c[1]); vo.w = pk2(c[2], c[3]); }
        else { const bf16_t* src = PROJ + (size_t)(MCTX + b * 1024 + (i - 256)) * NIN + 2048 + h * 128 + cgp * 8;
            ko = *(const u32x4*)src; vo = *(const u32x4*)(src + 512); }
        *(u32x4*)(KEL + (size_t)e * 128 + cgp * 8) = ko; *(u32x4*)(VEL + (size_t)e * 128 + cgp * 8) = vo;
    }
    for (int u = gt; u < 16 * 4 * 256 * 16; u += GT) {
        const int cgp = u & 15; const int e = u >> 4; const int t = e & 255, bh = e >> 8, h = bh & 3, b = bh >> 2;
        const bf16_t* src = PROJ + (size_t)(b * 256 + t) * NIN + 2048 + h * 128 + cgp * 8;
        *(u32x4*)(KEC + (size_t)e * 128 + cgp * 8) = *(const u32x4*)src; *(u32x4*)(VEC + (size_t)e * 128 + cgp * 8) = *(const u32x4*)(src + 512);
    }
    bf16_t* HYT = (bf16_t*)(p->ws + WS_HYT); const float* hc = p->in[I_HYCONV] + (size_t)l * 3 * 1536;
    for (int u = gw; u < 192 * 24; u += NGW) {
        const int rb = u / 24, cb = u - rb * 24, ch = cb * 64 + lane, r0 = rb * 64;
        const int Lseq = r0 < MCTX ? 256 : 1024; const int t0 = (r0 < MCTX ? r0 : r0 - MCTX) & (Lseq - 1);
        const float w0 = hc[ch], w1 = hc[1536 + ch], w2 = hc[3072 + ch];
        const bf16_t* src = PROJ + (size_t)r0 * NIN + 3584 + ch;
        bf16_t raw[66];
#pragma unroll
        for (int i = 0; i < 66; ++i) raw[i] = src[(long)(i - 1) * NIN];
        float xp = t0 > 0 ? bf2f(raw[0]) : 0.f, xc = bf2f(raw[1]);
        unsigned pk[32];
#pragma unroll
        for (int i = 0; i < 64; i += 2) {
            const float xn = bf2f(raw[i + 2]);
            const float ya = w0 * xp + w1 * xc + w2 * xn;
            const float xn2 = (i < 62 || t0 + 64 < Lseq) ? bf2f(raw[i + 3]) : 0.f;
            const float yb = w0 * xc + w1 * xn + w2 * xn2;
            pk[i >> 1] = pk2(ya, yb); xp = xn; xc = xn2;
        }
        bf16_t* dst = HYT + (size_t)ch * MROWS + r0;
#pragma unroll
        for (int i = 0; i < 8; ++i) { u32x4 o; o.x = pk[4 * i]; o.y = pk[4 * i + 1]; o.z = pk[4 * i + 2]; o.w = pk[4 * i + 3]; *(u32x4*)(dst + 8 * i) = o; }
    }
}
template <int TPW, int NB>
__device__ __forceinline__ void hyena_item(KP p, LAS unsigned char* lds, int c, int l) {
    constexpr int L = TPW * 128, CS = 2 * L + 128, RS = L + 16, ROWBASE = (NB == 8) ? MCTX : 0;
    LAS bf16_t* gc = (LAS bf16_t*)lds; LAS bf16_t* U0 = gc + 8 * CS; LAS bf16_t* U1 = U0 + NB * RS;
    const int tid = opaque_tid(), w = tid >> 6, lane = tid & 63, i = lane & 15, kq = lane >> 4;
    const bf16_t* hyt = (const bf16_t*)(p->ws + WS_HYT) + (size_t)c * MROWS + ROWBASE;
    const bf16_t* GF = (const bf16_t*)(p->ws + (NB == 8 ? WS_GF1 : WS_GF0) + (size_t)l * GF_LSTRIDE);
    bf16_t* CC = (bf16_t*)(p->ws + WS_CONCAT);
    for (int idx = tid * 8; idx < NB * L; idx += 512 * 8) { const int b = idx / L, m = idx - b * L; *(LAS u32x4*)(U0 + b * RS + m) = *(const u32x4*)(hyt + idx); }
#pragma unroll 1
    for (int o = 0; o < 2; ++o) {
        const bf16_t* G = GF + ((size_t)o * 512 + c) * (2 * L);
        { constexpr int NCH = 2 * L / 8;
          for (int idx = tid; idx < NCH * 8; idx += 512) { const int ch = idx % NCH, s = idx / NCH; const u32x4 gv = *(const u32x4*)(G + ch * 8);
              LAS bf16_t* d = gc + s * CS + 8 * ((s & 1) + 4 * (s >> 1)) + ch * 8 + s;
              d[0] = (bf16_t)(gv.x & 0xffffu); d[1] = (bf16_t)(gv.x >> 16); d[2] = (bf16_t)(gv.y & 0xffffu); d[3] = (bf16_t)(gv.y >> 16);
              d[4] = (bf16_t)(gv.z & 0xffffu); d[5] = (bf16_t)(gv.z >> 16); d[6] = (bf16_t)(gv.w & 0xffffu); d[7] = (bf16_t)(gv.w >> 16); }
          if (tid < 8) { for (int y = 0; y < tid; ++y) gc[tid * CS + 8 * ((tid & 1) + 4 * (tid >> 1)) + y] = (bf16_t)0; } }
        __syncthreads();
        const LAS bf16_t* Uin = o ? U1 : U0;
        f32x4 acc[TPW];
#pragma unroll
        for (int t = 0; t < TPW; ++t) acc[t] = (f32x4){0.f, 0.f, 0.f, 0.f};
        const LAS bf16_t* bp = Uin + (i & (NB - 1)) * RS + kq * 8;
        const LAS bf16_t* ap = gc + (i & 7) * CS + 8 * ((i & 1) + 4 * ((i & 7) >> 1)) + kq * 8 - (i & 8) + L - w * TPW * 16;
#pragma unroll 8
        for (int m0 = 0; m0 < L; m0 += 32) {
            const bf16x8 B = *(const LAS bf16x8*)(bp + m0);
#pragma unroll
            for (int t = 0; t < TPW; ++t) { const bf16x8 A = *(const LAS bf16x8*)(ap + m0 - t * 16); acc[t] = __builtin_amdgcn_mfma_f32_16x16x32_bf16(A, B, acc[t], 0, 0, 0); }
        }
        const float bias = p->in[I_HYBIAS][(l * 2 + o) * 512 + c];
        const int b = i, rq = kq;
        if (b < NB) {
            u32x2 xga[TPW];
#pragma unroll
            for (int t = 0; t < TPW; ++t) xga[t] = *(const u32x2*)(hyt + (size_t)(1 + o) * 512 * MROWS + b * L + (w * TPW + t) * 16 + rq * 4);
#pragma unroll
            for (int t = 0; t < TPW; ++t) { const int n = (w * TPW + t) * 16 + rq * 4;
                const u32x2 vin = *(const LAS u32x2*)(Uin + b * RS + n); const u32x2 xg = xga[t];
                const float z0 = bflo(xg.x) * (acc[t][0] + bflo(vin.x) * bias), z1 = bfhi(xg.x) * (acc[t][1] + bfhi(vin.x) * bias),
                            z2 = bflo(xg.y) * (acc[t][2] + bflo(vin.y) * bias), z3 = bfhi(xg.y) * (acc[t][3] + bfhi(vin.y) * bias);
                if (o == 0) { u32x2 zo; zo.x = pk2(z0, z1); zo.y = pk2(z2, z3); *(LAS u32x2*)(U1 + b * RS + n) = zo; }
                else { bf16_t* d = CC + (size_t)(ROWBASE + b * L + n) * DM + 1536 + c; d[0] = (bf16_t)f2bf(z0); d[DM] = (bf16_t)f2bf(z1); d[2 * DM] = (bf16_t)f2bf(z2); d[3 * DM] = (bf16_t)f2bf(z3); } }
        }
        __syncthreads();
    }
}
__device__ __forceinline__ float log2_sigmoid(float x) { return -log1pf(__expf(-x)) * 1.4426950408889634f; }
__device__ __forceinline__ void mix_phase(KP p, LAS unsigned char* ldsl, char* ldsg, int l) {
    unsigned* ctr = (unsigned*)(p->ws + WS_CTL) + 64 * (1 + l);
    LAS int* s_item = (LAS int*)(ldsl + LDS_ITEM_OFF);
    const bf16_t* PROJ = (const bf16_t*)(p->ws + WS_PROJ); bf16_t* CC = (bf16_t*)(p->ws + WS_CONCAT);
    const bf16_t* QN = (const bf16_t*)(p->ws + WS_QN);
    const float* rd = p->in[I_RDEC] + l * 8;
    for (;;) {
        if (threadIdx.x == 0) *s_item = (int)atomicAdd(ctr, 1u);
        __syncthreads();
        const int it = *s_item;
        __syncthreads();
#ifdef PROBE_DUP_LO
        if (it >= 1664 + (PROBE_DUP_HI - PROBE_DUP_LO)) break;
        const int it_orig = it; (void)it_orig;
#define it (it_orig >= 1664 ? it_orig - 1664 + PROBE_DUP_LO : it_orig)
#else
        if (it >= 1664) {
#ifdef PROBE_TAIL
            if (threadIdx.x == 0) { const unsigned t = (unsigned)__builtin_amdgcn_s_memrealtime(); unsigned* w = (unsigned*)(p->ws + WS_CTL) + 64 * (8 + 2 * l); atomicMin(w, t); atomicMax(w + 64, t); }
#endif
            break; }
#endif
        if ((it >= 128 && it < 384) || (it >= 896 && it < 1024)) {
            const bool lat = it < 384; const int j = lat ? it - 128 : it - 896;
            const int b = lat ? j >> 5 : j >> 3, h = lat ? (j >> 2) & 7 : j & 7, qb = lat ? j & 3 : 0;
            const size_t row = lat ? (size_t)(MCTX + b * 1024 + qb * 256) : (size_t)b * 256; const int seq = lat ? 1536 : 256;
            const size_t kvo = (size_t)(b * 2 + (h >> 2)) * seq * 128;
            att::attn_dense_body<1024, 128, 2048>(QN + row * 1024 + h * 128, (const bf16_t*)(p->ws + (lat ? WS_KBL : WS_KBC)) + kvo, (const bf16_t*)(p->ws + (lat ? WS_VBL : WS_VBC)) + kvo,
                CC + row * DM + h * 128, seq, ldsg);
        } else if (it < 128 || (it >= 1024 && it < 1088)) {
            const bool lat = it < 128; const int j = lat ? it : it - 1024;
            const int b = lat ? j >> 4 : j >> 2, h = lat ? (j >> 2) & 3 : j & 3, qb = lat ? j & 3 : 0;
            const size_t row = lat ? (size_t)(MCTX + b * 1024 + qb * 256) : (size_t)b * 256; const int seq = lat ? 1280 : 256;
            const size_t kvo = (size_t)(b * 4 + h) * seq * 128;
            att::retn_body<0, NIN>(PROJ + row * NIN + 1536 + h * 128, (const bf16_t*)(p->ws + (lat ? WS_KEL : WS_KEC)) + kvo, (const bf16_t*)(p->ws + (lat ? WS_VEL : WS_VEC)) + kvo,
                seq, lat ? 4 : 0, qb * 256, lat ? 1024 : 256, log2_sigmoid(rd[h]), log2_sigmoid(rd[4 + h]), PROJ + row * NIN + 3072 + h * 128, CC + row * DM + 1024 + h * 128, nullptr, ldsg);
        } else if (it < 896) {
            hyena_item<8, 8>(p, ldsl, it - 384, l);
        } else if (it < 1152) {
            const int j = it - 1088, b = j >> 2, h = j & 3;
            att::retn_body<1, NIN>((const bf16_t*)(p->ws + WS_IDQ), (const bf16_t*)(p->ws + WS_KEC) + (size_t)(b * 4 + h) * 256 * 128, (const bf16_t*)(p->ws + WS_VEC) + (size_t)(b * 4 + h) * 256 * 128,
                256, 0, 0, 256, log2_sigmoid(rd[h]), log2_sigmoid(rd[4 + h]), nullptr, nullptr, p->out + OUT_ST + (size_t)((b * 2 + l) * 2 * 4 + h) * 16384, ldsg);
        } else {
            hyena_item<2, 16>(p, ldsl, it - 1152, l);
        }
    }
}
#ifdef PROBE_DUP_LO
#undef it
#endif
__device__ __forceinline__ void p0_phase(KP p, LAS unsigned char* ldsl) {
    unsigned* ctr = (unsigned*)(p->ws + WS_CTL) + 64 * 3;
    LAS int* s_item = (LAS int*)(ldsl + LDS_ITEM_OFF);
    for (;;) {
        __syncthreads();
        if (threadIdx.x == 0) *s_item = (int)atomicAdd(ctr, 1u);
        __syncthreads();
        const int it = *s_item;
        if (it >= 192 + 320 + T_IN / 8) break;
        if (it < 192) adaln_item(p, ldsl, it);
        else if (it < 512) filter_items(p, ldsl, (it - 192) / 160, (it - 192) % 160, (it - 192) % 160 + 1, 1);
        else convert_block_item(p, ldsl, 0, (it - 512) * 8);
    }
    __syncthreads();
}
__device__ __forceinline__ void side_work(KP p, LAS unsigned char* ldsl, int layer, int limit) {
    unsigned* ctr = (unsigned*)(p->ws + WS_CTL) + 64 * (layer ? 4 : 5);
    const int total = layer ? T_ALL / 8 : (T_ALL - T_IN) / 8;
    LAS int* s_item = (LAS int*)(ldsl + LDS_ITEM_OFF);
    for (;;) {
        __syncthreads();
        if (threadIdx.x == 0) { int v = total; if ((int)__hip_atomic_load(ctr, __ATOMIC_RELAXED, __HIP_MEMORY_SCOPE_AGENT) < limit) v = (int)atomicAdd(ctr, 1u); *s_item = v; }
        __syncthreads();
        const int it = *s_item;
        if (it >= total) break;
        convert_block_item(p, ldsl, layer, (layer ? 0 : T_IN) + it * 8);
    }
    __syncthreads();
}
#define XB_TMO      128
#define XB_XCNT(j)  (256  + 64 * (j))
#define XB_XSUB(j)  (1280 + 64 * (j))
#define XB_XGEN(j)  (2304 + 64 * (j))
#define XB_TOP      3328
#define XB_TOPGEN   3392
#define XCD_BAR_WORDS 3456
#define XB_SPIN_CAP (1u << 18)

__device__ __forceinline__ unsigned xb_ld(unsigned* p)              { return __hip_atomic_load(p, __ATOMIC_RELAXED, __HIP_MEMORY_SCOPE_AGENT); }
__device__ __forceinline__ unsigned xb_add(unsigned* p, unsigned v) { return __hip_atomic_fetch_add(p, v, __ATOMIC_RELAXED, __HIP_MEMORY_SCOPE_AGENT); }
__device__ __forceinline__ unsigned xb_xcc_id() { return (unsigned)__builtin_amdgcn_s_getreg((3 << 11) | 20) & 0xFu; }
#define XB_SPIN(cond, bar) do { unsigned _sp = 0; while (cond) { __builtin_amdgcn_s_sleep(1); \
    if ((++_sp & 255u) == 0u) { if (xb_ld(&(bar)[XB_TMO])) break; if (_sp > XB_SPIN_CAP) { atomicAdd(&(bar)[XB_TMO], 1u); break; } } } } while (0)

struct XcdBarrier {
    unsigned* bar; unsigned x;
    volatile LAS unsigned* st;
};

__device__ __forceinline__ XcdBarrier xcd_barrier_post(unsigned* bar, volatile LAS unsigned* st) {
    XcdBarrier b; b.bar = bar; b.x = xb_xcc_id(); b.st = st;
    if (threadIdx.x == 0) (void)xb_add(&bar[XB_XCNT(b.x)], 1u);
    return b;
}
__device__ __forceinline__ void xcd_barrier_complete(unsigned* bar, unsigned x, unsigned& nloc, unsigned& nx) {
    const unsigned G = gridDim.x * gridDim.y * gridDim.z;
    unsigned sum, cnt, mine, sp = 0u;
    for (;;) {
        sum = 0u; cnt = 0u; mine = 0u;
#pragma unroll
        for (unsigned j = 0; j < 16; ++j) { const unsigned c = xb_ld(&bar[XB_XCNT(j)]); sum += c; cnt += (c > 0u) ? 1u : 0u; mine = (j == x) ? c : mine; }
        if (sum == G) break;
        __builtin_amdgcn_s_sleep(1);
        if ((++sp & 255u) == 0u) { if (xb_ld(&bar[XB_TMO])) break; if (sp > XB_SPIN_CAP) { atomicAdd(&bar[XB_TMO], 1u); break; } }
    }
    nloc = mine > 0u ? mine : 1u; nx = cnt > 0u ? cnt : 1u;
}

__device__ __forceinline__ void xcd_barrier(const XcdBarrier& b) {
    asm volatile("s_waitcnt vmcnt(0)" ::: "memory");
    __syncthreads();
    if (threadIdx.x == 0) {
        unsigned* bar = b.bar;
        __builtin_amdgcn_s_waitcnt(0);
        unsigned nloc = b.st[0], nx = b.st[1];
        if (nloc == 0u) { xcd_barrier_complete(bar, b.x, nloc, nx); b.st[0] = nloc; b.st[1] = nx; }
        const unsigned old = xb_add(&bar[XB_XSUB(b.x)], 1u);
        const unsigned gen = old / nloc;
        if (old + 1u == (gen + 1u) * nloc) {
            __builtin_amdgcn_fence(__ATOMIC_RELEASE, "agent");
            asm volatile("s_waitcnt vmcnt(0)" ::: "memory");
            const unsigned og = xb_add(&bar[XB_TOP], 1u);
            const unsigned tg = og / nx;
            if (og + 1u == (tg + 1u) * nx) xb_add(&bar[XB_TOPGEN], 1u);
            else XB_SPIN(xb_ld(&bar[XB_TOPGEN]) == tg, bar);
            __builtin_amdgcn_fence(__ATOMIC_ACQUIRE, "agent");
            xb_add(&bar[XB_XGEN(b.x)], 1u);
            asm volatile("s_waitcnt vmcnt(0)" ::: "memory");
        } else {
            XB_SPIN(xb_ld(&bar[XB_XGEN(b.x)]) == gen, bar);
            __builtin_amdgcn_fence(__ATOMIC_ACQUIRE, "agent");
            asm volatile("s_waitcnt vmcnt(0)" ::: "memory");
        }
    }
    __syncthreads();
}

#ifndef SIDE_L0
#define SIDE_L0 500
#endif
#ifndef SIDE_L1
#define SIDE_L1 1100
#endif
#ifndef SIDE_L2
#define SIDE_L2 1504
#endif
#ifndef PROBE_MASK
#define PROBE_MASK 0
#endif
#ifndef PROBE_K
#define PROBE_K 2
#endif
#define PH_BEGIN(bit) do { if (PROBE_MASK && ((PROBE_MASK >> (bit)) & 1) && blockIdx.x == 0 && threadIdx.x == 0) *(LAS unsigned long long*)(ldsl + LDS_BYTES - 48) = __builtin_amdgcn_s_memrealtime(); } while (0)
#define PH_END(bit) do { if (PROBE_MASK && ((PROBE_MASK >> (bit)) & 1) && blockIdx.x == 0 && threadIdx.x == 0) *(LAS unsigned long long*)(ldsl + LDS_BYTES - 40) += __builtin_amdgcn_s_memrealtime() - *(LAS unsigned long long*)(ldsl + LDS_BYTES - 48); } while (0)
#define GSYNC() do { XcdBarrier b_; b_.bar = (unsigned*)(kp_fresh()->ws + WS_CTL + 65536); b_.x = xb_xcc_id(); b_.st = (volatile LAS unsigned*)(ldsl + LDS_BYTES - 32); xcd_barrier(b_); } while (0)
template <int l>
__device__ __forceinline__ void run_layer(LAS unsigned char* ldsl, unsigned char* lds, const int G) {
        PH_BEGIN(2);
        { KP q = kp_fresh(); pg8::Gemm g{(const bf16_t*)(q->ws + WS_H), (const bf16_t*)(q->ws + WS_WIN + wofs(l)), MROWS, NIN, DM}; pg8::StaticOrder S; S.init(MROWS, NIN, opaque_s(G), opaque_s((int)blockIdx.x));
          pg8::EpiBf16 E{(bf16_t*)(q->ws + WS_PROJ), NIN}; pg8::gemm_phase<pg8::EpiBf16, pg8::StaticOrder, true, true>(ldsl, g, S, E); }
        if (l == 0) side_work(kp_fresh(), ldsl, 0, 400);
        GSYNC();
        PH_END(2); PH_BEGIN(3);
        prep_phase(kp_fresh(), l);
        GSYNC();
        PH_END(3); PH_BEGIN(4);
        mix_phase(kp_fresh(), ldsl, (char*)lds, l);
        if (l == 0) side_work(kp_fresh(), ldsl, 0, 832);
        GSYNC();
        PH_END(4); PH_BEGIN(5);
        { KP q = kp_fresh(); pg8::Gemm g{(const bf16_t*)(q->ws + WS_CONCAT), (const bf16_t*)(q->ws + WS_WOUT + wofs(l)), MROWS, DM, DM}; pg8::StaticOrder S; S.init(MROWS, DM, opaque_s(G), opaque_s((int)blockIdx.x));
          pg8::EpiResid E{l == 0 ? q->in[I_XP] : nullptr, q->in[I_XS], (const bf16_t*)(q->ws + WS_YB), (bf16_t*)(q->ws + WS_YB), (const float*)(q->ws + WS_MOD) + (size_t)l * 9 * 12288 + 2 * 2048, 1.41421356237f,
                          (const float*)(q->ws + WS_STATS2), q->in[I_LN2W], q->in[I_LN2B]};
          pg8::gemm_phase<pg8::EpiResid, pg8::StaticOrder, true, true>(ldsl, g, S, E); }
        if (l == 0) { side_work(kp_fresh(), ldsl, 0, 1184); side_work(kp_fresh(), ldsl, 1, SIDE_L0); }
        GSYNC();
        PH_END(5); PH_BEGIN(6);
        { KP q = kp_fresh(); ln_phase(q, q->in[I_LN1W] + l * DM, q->in[I_LN1B] + l * DM, (const float*)(q->ws + WS_MOD) + (size_t)l * 9 * 12288 + 3 * 2048, (float*)(q->ws + WS_STATS1), nullptr); }
        GSYNC();
        PH_END(6); PH_BEGIN(7);
        { KP q = kp_fresh(); pg8::Gemm g{(const bf16_t*)(q->ws + WS_H), (const bf16_t*)(q->ws + WS_WUP + wofs(l)), MROWS, NUP, DM}; pg8::StaticOrder S; S.init(MROWS, NUP, opaque_s(G), opaque_s((int)blockIdx.x));
          pg8::EpiGate E{(bf16_t*)(q->ws + WS_ACT), (bf16_t*)(q->ws + WS_STASH), q->in[I_FFNCONV] + (size_t)l * 3 * NUP}; pg8::gemm_phase<pg8::EpiGate, pg8::StaticOrder, true, true>(ldsl, g, S, E); }
        if (l == 0) side_work(kp_fresh(), ldsl, 1, SIDE_L1);
        GSYNC();
        PH_END(7); PH_BEGIN(8);
        gate_fixup_phase(kp_fresh(), l);
        GSYNC();
        PH_END(8); PH_BEGIN(9);
        { KP q = kp_fresh(); pg8::Gemm g{(const bf16_t*)(q->ws + WS_ACT), (const bf16_t*)(q->ws + WS_WDN + wofs(l)), MROWS, DM, DFF}; pg8::StaticOrder S; S.init(MROWS, DM, opaque_s(G), opaque_s((int)blockIdx.x));
          pg8::EpiResid E{nullptr, nullptr, (const bf16_t*)(q->ws + WS_YB), (bf16_t*)(q->ws + WS_YB), (const float*)(q->ws + WS_MOD) + (size_t)l * 9 * 12288 + 5 * 2048, 1.41421356237f,
                          (const float*)(q->ws + WS_STATS1), q->in[I_LN1W] + l * DM, q->in[I_LN1B] + l * DM};
          pg8::gemm_phase<pg8::EpiResid, pg8::StaticOrder, true, true>(ldsl, g, S, E); }
        if (l == 0) side_work(kp_fresh(), ldsl, 1, SIDE_L2);
        GSYNC();
        PH_END(9); PH_BEGIN(10);
        { KP q = kp_fresh(); ln_phase(q, q->in[I_LN2W] + l * DM, q->in[I_LN2B] + l * DM, l == 0 ? (const float*)(q->ws + WS_MOD) + (size_t)9 * 12288 : nullptr, l == 0 ? (float*)(q->ws + WS_STATS2) : nullptr, l == 0 ? nullptr : q->out); }
        if (l == 0) { side_work(kp_fresh(), ldsl, 1, T_ALL / 8); GSYNC(); }
        PH_END(10);
}
__global__ void __launch_bounds__(512, 2) mega(Params p_unused) {
    extern __shared__ __attribute__((aligned(16))) unsigned char lds[];
    cg::grid_group grid = cg::this_grid();
    LAS unsigned char* ldsl = (LAS unsigned char*)lds;
    const int G = gridDim.x;
    KP p = kp_fresh();
    if (threadIdx.x < 2) ((volatile LAS unsigned*)(ldsl + LDS_BYTES - 32))[threadIdx.x] = 0u;
    __syncthreads();
    (void)xcd_barrier_post((unsigned*)(p->ws + WS_CTL + 65536), (volatile LAS unsigned*)(ldsl + LDS_BYTES - 32));
    if (PROBE_MASK && threadIdx.x == 0) *(LAS unsigned long long*)(ldsl + LDS_BYTES - 40) = 0ull;
    PH_BEGIN(0);
    { bf16_t* IDQ = (bf16_t*)(p->ws + WS_IDQ);
      for (int u = blockIdx.x * 512 + threadIdx.x; u < 256 * 128; u += G * 512) { const int n = u >> 7, j = u & 127; IDQ[(size_t)n * NIN + j] = (j == (n & 127)) ? (bf16_t)0x3F80 : (bf16_t)0; } }
    p0_phase(kp_fresh(), ldsl);
    if (kp_fresh()->pad != 0ull) grid.sync();
    GSYNC();
#ifdef PROBE_XSYNC
    for (int xs = 0; xs < PROBE_XSYNC; ++xs) GSYNC();
#endif
    PH_END(0); PH_BEGIN(1);
    mod0_phase(kp_fresh());
    GSYNC();
    PH_END(1);
    run_layer<0>(ldsl, lds, G);
    run_layer<1>(ldsl, lds, G);
#ifdef PROBE_TAIL
    GSYNC();
    if (blockIdx.x == 0 && threadIdx.x == 0) { const unsigned* w = (const unsigned*)(kp_fresh()->ws + WS_CTL);
        const unsigned t0v = __hip_atomic_load(w + 64 * 4, __ATOMIC_RELAXED, __HIP_MEMORY_SCOPE_AGENT), t1v = __hip_atomic_load(w + 64 * 5, __ATOMIC_RELAXED, __HIP_MEMORY_SCOPE_AGENT);
        const unsigned t2v = __hip_atomic_load(w + 64 * 6, __ATOMIC_RELAXED, __HIP_MEMORY_SCOPE_AGENT), t3v = __hip_atomic_load(w + 64 * 7, __ATOMIC_RELAXED, __HIP_MEMORY_SCOPE_AGENT);
        const unsigned long long want = (unsigned long long)PROBE_TAIL * ((t1v - t0v) + (t3v - t2v)); const unsigned long long s0 = __builtin_amdgcn_s_memrealtime();
        while (__builtin_amdgcn_s_memrealtime() - s0 < want) __builtin_amdgcn_s_sleep(32); }
#endif
    if (PROBE_MASK && blockIdx.x == 0 && threadIdx.x == 0) { const unsigned long long t0 = __builtin_amdgcn_s_memrealtime(), want = (unsigned long long)PROBE_K * *(LAS unsigned long long*)(ldsl + LDS_BYTES - 40);
        while (__builtin_amdgcn_s_memrealtime() - t0 < want) __builtin_amdgcn_s_sleep(32); }
}
extern "C" void kernel_launch(void* const* d_in, const int* in_sizes, int n_in, void* d_out, int out_size, void* d_ws, size_t ws_size, hipStream_t stream) {
    static int grid = 0;
    if (grid == 0) {
        if (n_in != 29 || out_size != 33554432 || ws_size < WS_END) { fprintf(stderr, "kernel_launch: unexpected shapes: n_in %d out %d ws %zu (need %zu)\n", n_in, out_size, ws_size, (size_t)WS_END); grid = -1; return; }
        int dev = 0, cus = 0, per_cu = 0;
        (void)hipGetDevice(&dev); (void)hipDeviceGetAttribute(&cus, hipDeviceAttributeMultiprocessorCount, dev);
        if (hipFuncSetAttribute((const void*)mega, hipFuncAttributeMaxDynamicSharedMemorySize, LDS_BYTES) != hipSuccess) { fprintf(stderr, "kernel_launch: hipFuncSetAttribute failed\n"); grid = -1; return; }
        if (hipOccupancyMaxActiveBlocksPerMultiprocessor(&per_cu, (const void*)mega, 512, LDS_BYTES) != hipSuccess || per_cu < 1) { fprintf(stderr, "kernel_launch: occupancy query says %d\n", per_cu); per_cu = 1; }
        (void)hipGetLastError();
        grid = cus > 0 ? cus : 256;
    }
    if (grid < 0) return;
    Params p{};
    for (int i = 0; i < 29; ++i) p.in[i] = (const float*)d_in[i];
    p.out = (float*)d_out; p.ws = (unsigned char*)d_ws; p.pad = 0ull;
    if (hipMemsetAsync((char*)d_ws + WS_CTL, 0, 2 * MiB, stream) != hipSuccess) { fprintf(stderr, "kernel_launch: hipMemsetAsync failed\n"); return; }
    void* args[] = {&p};
    const hipError_t e = hipLaunchCooperativeKernel((const void*)mega, dim3(grid), dim3(512), args, LDS_BYTES, stream);
    if (e != hipSuccess) fprintf(stderr, "kernel_launch: cooperative launch failed: %s (grid %d)\n", hipGetErrorString(e), grid);
}
```

```cpp
#include <hip/hip_runtime.h>
#include <hip/hip_cooperative_groups.h>
#include <cstdio>
#include <cstdint>
namespace cg = cooperative_groups;
__device__ __forceinline__ int opaque_tid() { int t = threadIdx.x; asm volatile("" : "+v"(t)); return t; }
__device__ __forceinline__ int opaque_s(int v) { asm volatile("" : "+s"(v)); return v; }
namespace pg8 {
#define PG8_LAS __attribute__((address_space(3)))
typedef unsigned short bf16_t;
typedef short bf16x8 __attribute__((ext_vector_type(8)));
typedef float f32x4 __attribute__((ext_vector_type(4)));
typedef float f32x2 __attribute__((ext_vector_type(2)));
typedef unsigned u32x4 __attribute__((ext_vector_type(4)));
constexpr int BM = 256, BK = 64, HALF = 128, HTB = HALF * BK * 2  , STAGE_BYTES = 8 * HTB, NXCD = 8, WGM = 8;

__host__ __device__ __forceinline__ int lds_byte(int r, int c) { const int st = (r >> 4) * 2 + (c >> 5), rr = r & 15, cc = c & 31, ob = rr * 64 + cc * 2; return st * 1024 + (ob ^ (((ob >> 9) & 1) << 5)); }
__host__ __device__ __forceinline__ void stage_rc(int b, int& R, int& C) { const int st = b / 1024, sb = b % 1024, swz = sb ^ (((sb >> 9) & 1) << 5); R = (st >> 1) * 16 + swz / 64; C = (st & 1) * 32 + (swz % 64) / 2; }
__host__ __device__ __forceinline__ int perm32(int rho) { const int n = rho >> 4, i = rho & 15; return 8 * (i >> 2) + 4 * n + (i & 3); }

struct Unit { int pm, pn; };
struct Gemm { const bf16_t* A; const bf16_t* Bt; int M, N, K; };

struct StaticOrder {
    int nM, nN, nwg, G, c;
    __host__ __device__ void init(int M, int N, int G_, int c_) { nM = M / BM; nN = N / BM; nwg = nM * nN; G = G_; c = c_; }
    __host__ __device__ bool next(int i, Unit& u) const {
        const long L = (long)i * G + c; if (L >= nwg) return false;
        int wgid = (int)L; { const int q = nwg / NXCD, r = nwg % NXCD, xcd = wgid % NXCD, off = wgid / NXCD; wgid = (xcd < r ? xcd * (q + 1) : r * (q + 1) + (xcd - r) * q) + off; }
        const int nig = WGM * nN, gid = wgid / nig, fm = gid * WGM, gsz = (nM - fm) < WGM ? (nM - fm) : WGM;
        u.pm = fm + ((wgid % nig) % gsz); u.pn = (wgid % nig) / gsz; return true;
    }
    __device__ __forceinline__ void a_ready(const Unit&) const {}
    __device__ __forceinline__ void done(const Unit&) const {}
};
__device__ __forceinline__ unsigned cvt_pk_bf16(float lo, float hi) { unsigned r; asm volatile("v_cvt_pk_bf16_f32 %0, %1, %2" : "=v"(r) : "v"(lo), "v"(hi)); return r; }
struct EpiBf16 {
    static constexpr bool PERM = true, AFTER_DRAIN = false;
    bf16_t* O; int ldc;
    __device__ __forceinline__ void operator()(const f32x4 (&acc)[2][2][4][2], const Unit& u, int wr, int wc, int fr, int fq) const {
        const int row0 = u.pm * BM + wr * 64 + fr, col0 = u.pn * BM + wc * 32 + 8 * fq;
#pragma unroll
        for (int ai = 0; ai < 2; ++ai) {
#pragma unroll
            for (int m = 0; m < 4; ++m) { bf16_t* rowp = O + (size_t)(row0 + ai * HALF + m * 16) * ldc + col0;
#pragma unroll
                for (int bj = 0; bj < 2; ++bj) { const f32x4 v0 = acc[ai][bj][m][0], v1 = acc[ai][bj][m][1];
                    u32x4 w; w.x = cvt_pk_bf16(v0[0], v0[1]); w.y = cvt_pk_bf16(v0[2], v0[3]); w.z = cvt_pk_bf16(v1[0], v1[1]); w.w = cvt_pk_bf16(v1[2], v1[3]);
                    *(u32x4*)(rowp + bj * HALF) = w; } } }
    }
};

__device__ __forceinline__ float dpp_ror1(float v) { return __builtin_bit_cast(float, __builtin_amdgcn_update_dpp(0, __builtin_bit_cast(int, v), 0x121, 0xf, 0xf, false)); }
__device__ __forceinline__ float dpp_ror15(float v) { return __builtin_bit_cast(float, __builtin_amdgcn_update_dpp(0, __builtin_bit_cast(int, v), 0x12f, 0xf, 0xf, false)); }
typedef unsigned u32x2e __attribute__((ext_vector_type(2)));
struct EpiGate {
    static constexpr bool PERM = true, AFTER_DRAIN = false;
    bf16_t* ACT; bf16_t* STASH; const float* cw;
    __device__ __forceinline__ void operator()(const f32x4 (&acc)[2][2][4][2], const Unit& u, int wr, int wc, int fr, int fq) const {
        const int chb = u.pn * 128 + wc * 32 + 8 * fq;
        const int rowg = u.pm * BM + wr * 64;
        f32x4 cwv[2][6];
#pragma unroll
        for (int n = 0; n < 2; ++n) { const int ch = chb + 4 * n;
            cwv[n][0] = *(const f32x4*)(cw + ch); cwv[n][1] = *(const f32x4*)(cw + 11264 + ch); cwv[n][2] = *(const f32x4*)(cw + 2 * 11264 + ch);
            cwv[n][3] = *(const f32x4*)(cw + 5632 + ch); cwv[n][4] = *(const f32x4*)(cw + 11264 + 5632 + ch); cwv[n][5] = *(const f32x4*)(cw + 2 * 11264 + 5632 + ch); }
#pragma unroll
        for (int ai = 0; ai < 2; ++ai)
#pragma unroll
            for (int m = 0; m < 4; ++m) {
                float o[2][4];
#pragma unroll
                for (int n = 0; n < 2; ++n) {
                    const f32x4 g0 = cwv[n][0], g1 = cwv[n][1], g2 = cwv[n][2], u0 = cwv[n][3], u1 = cwv[n][4], u2 = cwv[n][5];
                    const f32x4 gc = acc[ai][0][m][n], uc = acc[ai][1][m][n];
                    const f32x4 gl = acc[ai][0][m > 0 ? m - 1 : 0][n], ul = acc[ai][1][m > 0 ? m - 1 : 0][n], gh = acc[ai][0][m < 3 ? m + 1 : 3][n], uh = acc[ai][1][m < 3 ? m + 1 : 3][n];
#pragma unroll
                    for (int j = 0; j < 4; ++j) {
                        const float gp = dpp_ror1(fr == 15 ? gl[j] : gc[j]), gn = dpp_ror15(fr == 0 ? gh[j] : gc[j]);
                        const float up = dpp_ror1(fr == 15 ? ul[j] : uc[j]), un = dpp_ror15(fr == 0 ? uh[j] : uc[j]);
                        const float G = g0[j] * gp + g1[j] * gc[j] + g2[j] * gn, U = u0[j] * up + u1[j] * uc[j] + u2[j] * un;
                        o[n][j] = G * __builtin_amdgcn_rcpf(1.f + __expf(-G)) * U; }
                }
                const int rho = m * 16 + fr, row = rowg + ai * HALF + rho;
                if (rho != 0 && rho != 63) { u32x4 w; w.x = cvt_pk_bf16(o[0][0], o[0][1]); w.y = cvt_pk_bf16(o[0][2], o[0][3]); w.z = cvt_pk_bf16(o[1][0], o[1][1]); w.w = cvt_pk_bf16(o[1][2], o[1][3]);
                    *(u32x4*)(ACT + (size_t)row * 5632 + chb) = w; }
                if (rho <= 1 || rho >= 62) { const int slot = rho <= 1 ? rho : rho - 60; bf16_t* sp = STASH + ((size_t)((row >> 6) * 4 + slot) * 2) * 5632 + chb;
                    const f32x4 ga = acc[ai][0][m][0], gb = acc[ai][0][m][1], ua = acc[ai][1][m][0], ub = acc[ai][1][m][1];
                    u32x4 a; a.x = cvt_pk_bf16(ga[0], ga[1]); a.y = cvt_pk_bf16(ga[2], ga[3]); a.z = cvt_pk_bf16(gb[0], gb[1]); a.w = cvt_pk_bf16(gb[2], gb[3]); *(u32x4*)sp = a;
                    u32x4 b; b.x = cvt_pk_bf16(ua[0], ua[1]); b.y = cvt_pk_bf16(ua[2], ua[3]); b.z = cvt_pk_bf16(ub[0], ub[1]); b.w = cvt_pk_bf16(ub[2], ub[3]); *(u32x4*)(sp + 5632) = b; }
            }
    }
};
struct EpiResid {
    static constexpr bool PERM = true, AFTER_DRAIN = false;
    const float* xp; const float* xs; const bf16_t* XB; bf16_t* YB; const float* gate; float alpha;
    const float* stats; const float* lnw; const float* lnb;
    __device__ __forceinline__ void operator()(const f32x4 (&acc)[2][2][4][2], const Unit& u, int wr, int wc, int fr, int fq) const {
        const int modrow = u.pm < 16 ? 0 : 1 + ((u.pm - 16) >> 2);
        const float* g = gate + (size_t)modrow * 12288;
        const int row0 = u.pm * BM + wr * 64 + fr, col0 = u.pn * BM + wc * 32 + 8 * fq;
#pragma unroll
        for (int bj = 0; bj < 2; ++bj) {
            const int co = col0 + bj * HALF;
            const f32x4 gv0 = *(const f32x4*)(g + co), gv1 = *(const f32x4*)(g + co + 4);
            if (xp != nullptr) {
                f32x4 xa[3][2];
#define EPR_LOADF(slot, gidx) do { const int r_ = row0 + ((gidx) >> 2) * HALF + ((gidx) & 3) * 16; const float* xr_ = (r_ < 4096 ? xp + (size_t)r_ * 2048 : xs + (size_t)(r_ - 4096) * 2048) + co; \
                    xa[slot][0] = *(const f32x4*)(xr_); xa[slot][1] = *(const f32x4*)(xr_ + 4); } while (0)
                EPR_LOADF(0, 0); EPR_LOADF(1, 1);
#pragma unroll
                for (int gi = 0; gi < 8; ++gi) { const int ai = gi >> 2, m = gi & 3; const int r = row0 + ai * HALF + m * 16;
                    if (gi + 2 < 8) EPR_LOADF((gi + 2) % 3, gi + 2);
                    const f32x4 o0 = xa[gi % 3][0] * alpha + gv0 * acc[ai][bj][m][0], o1 = xa[gi % 3][1] * alpha + gv1 * acc[ai][bj][m][1];
                    u32x4 w; w.x = cvt_pk_bf16(o0[0], o0[1]); w.y = cvt_pk_bf16(o0[2], o0[3]); w.z = cvt_pk_bf16(o1[0], o1[1]); w.w = cvt_pk_bf16(o1[2], o1[3]);
                    *(u32x4*)(YB + (size_t)r * 2048 + co) = w;
                    asm volatile("" ::: "memory"); }
#undef EPR_LOADF
            } else {
                const f32x4 wv0 = *(const f32x4*)(lnw + co), wv1 = *(const f32x4*)(lnw + co + 4), bv0 = *(const f32x4*)(lnb + co), bv1 = *(const f32x4*)(lnb + co + 4);
                u32x4 xb[4]; f32x2 sb[4];
#define EPR_LOADB(slot, gidx) do { const int r_ = row0 + ((gidx) >> 2) * HALF + ((gidx) & 3) * 16; xb[slot] = *(const u32x4*)(XB + (size_t)r_ * 2048 + co); sb[slot] = *(const f32x2*)(stats + 2 * (size_t)r_); } while (0)
                EPR_LOADB(0, 0); EPR_LOADB(1, 1); EPR_LOADB(2, 2);
#pragma unroll
                for (int gi = 0; gi < 8; ++gi) { const int ai = gi >> 2, m = gi & 3; const int r = row0 + ai * HALF + m * 16;
                    if (gi + 3 < 8) EPR_LOADB((gi + 3) % 4, gi + 3);
                    const u32x4 xw = xb[gi % 4]; const f32x2 sc = sb[gi % 4];
                    f32x4 x0, x1; x0[0] = __uint_as_float(xw.x << 16); x0[1] = __uint_as_float(xw.x & 0xffff0000u); x0[2] = __uint_as_float(xw.y << 16); x0[3] = __uint_as_float(xw.y & 0xffff0000u);
                    x1[0] = __uint_as_float(xw.z << 16); x1[1] = __uint_as_float(xw.z & 0xffff0000u); x1[2] = __uint_as_float(xw.w << 16); x1[3] = __uint_as_float(xw.w & 0xffff0000u);
                    x0 = (x0 - sc[0]) * sc[1] * wv0 + bv0; x1 = (x1 - sc[0]) * sc[1] * wv1 + bv1;
                    const f32x4 o0 = x0 * alpha + gv0 * acc[ai][bj][m][0], o1 = x1 * alpha + gv1 * acc[ai][bj][m][1];
                    u32x4 w; w.x = cvt_pk_bf16(o0[0], o0[1]); w.y = cvt_pk_bf16(o0[2], o0[3]); w.z = cvt_pk_bf16(o1[0], o1[1]); w.w = cvt_pk_bf16(o1[2], o1[3]);
                    *(u32x4*)(YB + (size_t)r * 2048 + co) = w;
                    asm volatile("" ::: "memory"); }
#undef EPR_LOADB
            }
        }
    }
};
template <class Epi, class Sched, bool ALIGN_EPI = false, bool SP2 = false>
__device__ __forceinline__ void gemm_phase(PG8_LAS unsigned char* lds, const Gemm g, const Sched& S, const Epi& E) {
    const int tid = ::opaque_tid(), wid = __builtin_amdgcn_readfirstlane(tid >> 6), lane = tid & 63, wr = wid >> 2, wc = wid & 3, fr = lane & 15, fq = lane >> 4;
    const int K = g.K, nt = K / BK;
    unsigned voffA[2], voffB[2];
#pragma unroll
    for (int i = 0; i < 2; ++i) { int R, C; stage_rc(tid * 16 + i * 8192, R, C); const int Rb = Epi::PERM ? ((R & ~31) + perm32(R & 31)) : R;
        voffA[i] = (unsigned)(R * K + C) * 2u; voffB[i] = (unsigned)(Rb * K + C) * 2u; }
    const size_t kstep = (size_t)(BK * 2);
    const size_t hstep = (size_t)HALF * K * 2;
    const size_t tstep = 2 * hstep;
    const unsigned ldsw = (unsigned)wid * 1024u;
    const int aoff = lds_byte(wr * 64 + fr, fq * 8), boff = lds_byte(wc * 32 + fr, fq * 8);
#define PG8_SA(b, h) (((b) * 2 + (h)) * HTB)
#define PG8_SB(b, h) ((4 + (b) * 2 + (h)) * HTB)
#define PG8_STAGE(bufoff, gbase, voff) do { _Pragma("unroll") for (int _i = 0; _i < 2; ++_i) \
        __builtin_amdgcn_global_load_lds((const unsigned*)((const char*)(gbase) + (voff)[_i]), (PG8_LAS unsigned*)(lds + (bufoff) + ldsw + _i * 8192), 16, 0, 0); } while (0)
#define PG8_LDA(dst, b, h) do { _Pragma("unroll") for (int m = 0; m < 4; ++m) _Pragma("unroll") for (int k = 0; k < 2; ++k) dst[m][k] = *(const PG8_LAS bf16x8*)(lds + PG8_SA(b, h) + aoff + m * 2048 + k * 1024); } while (0)
#define PG8_LDB(dst, b, h) do { _Pragma("unroll") for (int n = 0; n < 2; ++n) _Pragma("unroll") for (int k = 0; k < 2; ++k) dst[n][k] = *(const PG8_LAS bf16x8*)(lds + PG8_SB(b, h) + boff + n * 2048 + k * 1024); } while (0)
#define PG8_MMA(ai, bj, At, Bt) do { __builtin_amdgcn_s_setprio(1); _Pragma("unroll") for (int m = 0; m < 4; ++m) _Pragma("unroll") for (int n = 0; n < 2; ++n) _Pragma("unroll") for (int k = 0; k < 2; ++k) \
        acc[ai][bj][m][n] = __builtin_amdgcn_mfma_f32_16x16x32_bf16(Bt[n][k], At[m][k], acc[ai][bj][m][n], 0, 0, 0); __builtin_amdgcn_s_setprio(0); } while (0)
#define PG8_WAIT_V(n) asm volatile("s_waitcnt vmcnt(" #n ")" ::: "memory")
#define PG8_WAIT_L(n) asm volatile("s_waitcnt lgkmcnt(" #n ")" ::: "memory")
#define PG8_BAR __builtin_amdgcn_s_barrier()
#define PG8_SCHED __builtin_amdgcn_sched_barrier(0)
    Unit cur, nxt; int ui = 0;
    if (!S.next(0, cur)) return;
    f32x4 acc[2][2][4][2];
#pragma unroll
    for (int a = 0; a < 2; ++a)
#pragma unroll
        for (int b = 0; b < 2; ++b)
#pragma unroll
            for (int m = 0; m < 4; ++m)
#pragma unroll
                for (int n = 0; n < 2; ++n) acc[a][b][m][n] = (f32x4){0.f, 0.f, 0.f, 0.f};
    bf16x8 At[4][2], B0[2][2], B1[2][2];
    const char* cA = (const char*)g.A + (size_t)cur.pm * tstep; const char* cB = (const char*)g.Bt + (size_t)cur.pn * tstep;
    S.a_ready(cur);
    if constexpr (SP2) {
        PG8_STAGE(PG8_SB(0, 0), cB, voffB); PG8_STAGE(PG8_SB(0, 1), cB + hstep, voffB); PG8_STAGE(PG8_SA(0, 0), cA, voffA); PG8_STAGE(PG8_SA(0, 1), cA + hstep, voffA);
        if (wr == 1) PG8_BAR;
        PG8_WAIT_V(2); PG8_BAR;
        PG8_STAGE(PG8_SB(1, 0), cB + kstep, voffB); PG8_STAGE(PG8_SA(1, 0), cA + kstep, voffA); PG8_STAGE(PG8_SB(1, 1), cB + hstep + kstep, voffB);
        PG8_WAIT_V(6); PG8_BAR;
    } else {
        PG8_STAGE(PG8_SB(0, 0), cB, voffB); PG8_STAGE(PG8_SA(0, 0), cA, voffA); PG8_STAGE(PG8_SB(0, 1), cB + hstep, voffB); PG8_STAGE(PG8_SA(0, 1), cA + hstep, voffA);
        if (wr == 1) PG8_BAR;
        PG8_WAIT_V(4); PG8_BAR;
        PG8_STAGE(PG8_SB(1, 0), cB + kstep, voffB); PG8_STAGE(PG8_SA(1, 0), cA + kstep, voffA); PG8_STAGE(PG8_SB(1, 1), cB + hstep + kstep, voffB);
        PG8_WAIT_V(6); PG8_BAR;
    }
    for (;;) {
        const bool has_next = S.next(ui + 1, nxt);
        const char* nA = has_next ? (const char*)g.A + (size_t)nxt.pm * tstep : cA; const char* nB = has_next ? (const char*)g.Bt + (size_t)nxt.pn * tstep : cB;
        for (int t = 0; t < nt; t += 2) {
            const bool last = (t == nt - 2);
            const char* a1 = cA + (size_t)(t + 1) * kstep;
            const char* a2 = last ? nA : cA + (size_t)(t + 2) * kstep; const char* b2 = last ? nB : cB + (size_t)(t + 2) * kstep;
            const char* a3 = a2 + kstep; const char* b3 = b2 + kstep;
            if (last && has_next) S.a_ready(nxt);
            if constexpr (SP2) {
            PG8_LDB(B0, 0, 0); PG8_LDB(B1, 0, 1); PG8_SCHED; PG8_LDA(At, 0, 0); PG8_STAGE(PG8_SA(1, 1), a1 + hstep, voffA);
            PG8_WAIT_V(8); PG8_WAIT_L(0); PG8_BAR; PG8_MMA(0, 0, At, B0); PG8_MMA(0, 1, At, B1); PG8_BAR; PG8_SCHED;
            PG8_LDA(At, 0, 1); PG8_STAGE(PG8_SB(0, 0), b2, voffB); PG8_STAGE(PG8_SB(0, 1), b2 + hstep, voffB); PG8_STAGE(PG8_SA(0, 0), a2, voffA);
            PG8_WAIT_V(8); PG8_WAIT_L(0); PG8_BAR; PG8_MMA(1, 0, At, B0); PG8_MMA(1, 1, At, B1); PG8_BAR; PG8_SCHED;
            PG8_LDB(B0, 1, 0); PG8_LDB(B1, 1, 1); PG8_SCHED; PG8_LDA(At, 1, 0); PG8_STAGE(PG8_SA(0, 1), a2 + hstep, voffA);
            PG8_WAIT_V(8); PG8_WAIT_L(0); PG8_BAR; PG8_MMA(0, 0, At, B0); PG8_MMA(0, 1, At, B1); PG8_BAR; PG8_SCHED;
            PG8_LDA(At, 1, 1); PG8_STAGE(PG8_SB(1, 0), b3, voffB); PG8_STAGE(PG8_SB(1, 1), b3 + hstep, voffB); PG8_STAGE(PG8_SA(1, 0), a3, voffA);
            PG8_WAIT_V(8); PG8_WAIT_L(0); PG8_BAR; PG8_MMA(1, 0, At, B0); PG8_MMA(1, 1, At, B1); PG8_BAR; PG8_SCHED;
            } else {
            PG8_LDB(B0, 0, 0); PG8_SCHED; PG8_LDA(At, 0, 0); PG8_STAGE(PG8_SA(1, 1), a1 + hstep, voffA);
            PG8_WAIT_L(8); PG8_BAR; PG8_WAIT_L(0); PG8_MMA(0, 0, At, B0); PG8_BAR; PG8_SCHED;
            PG8_LDB(B1, 0, 1); PG8_STAGE(PG8_SB(0, 0), b2, voffB);
            PG8_BAR; PG8_WAIT_L(0); PG8_MMA(0, 1, At, B1); PG8_BAR;
            PG8_LDA(At, 0, 1); PG8_STAGE(PG8_SA(0, 0), a2, voffA);
            PG8_BAR; PG8_WAIT_L(0); PG8_MMA(1, 0, At, B0); PG8_BAR; PG8_SCHED;
            PG8_STAGE(PG8_SB(0, 1), b2 + hstep, voffB);
            PG8_WAIT_V(6); PG8_BAR; PG8_MMA(1, 1, At, B1); PG8_BAR;
            PG8_LDB(B0, 1, 0); PG8_SCHED; PG8_LDA(At, 1, 0); PG8_STAGE(PG8_SA(0, 1), a2 + hstep, voffA);
            PG8_WAIT_L(8); PG8_BAR; PG8_WAIT_L(0); PG8_MMA(0, 0, At, B0); PG8_BAR; PG8_SCHED;
            PG8_LDB(B1, 1, 1); PG8_STAGE(PG8_SB(1, 0), b3, voffB);
            PG8_BAR; PG8_WAIT_L(0); PG8_MMA(0, 1, At, B1); PG8_BAR;
            PG8_LDA(At, 1, 1); PG8_STAGE(PG8_SA(1, 0), a3, voffA);
            PG8_BAR; PG8_WAIT_L(0); PG8_MMA(1, 0, At, B0); PG8_BAR; PG8_SCHED;
            PG8_STAGE(PG8_SB(1, 1), b3 + hstep, voffB);
            PG8_WAIT_V(6); PG8_BAR; PG8_MMA(1, 1, At, B1); PG8_BAR;
            }
        }
        if constexpr (ALIGN_EPI) { if (wr == 0) PG8_BAR; }
        if constexpr (!Epi::AFTER_DRAIN) { E(acc, cur, wr, wc, fr, fq); S.done(cur); }
        if (!has_next) break;
#pragma unroll
        for (int a = 0; a < 2; ++a)
#pragma unroll
            for (int b = 0; b < 2; ++b)
#pragma unroll
                for (int m = 0; m < 4; ++m)
#pragma unroll
                    for (int n = 0; n < 2; ++n) acc[a][b][m][n] = (f32x4){0.f, 0.f, 0.f, 0.f};
        cur = nxt; cA = nA; cB = nB; ++ui;
        if constexpr (ALIGN_EPI) { if (wr == 1) PG8_BAR; }
    }
    PG8_WAIT_V(0);
    if constexpr (!ALIGN_EPI) { if (wr == 0) PG8_BAR; }
    PG8_BAR;
    if constexpr (Epi::AFTER_DRAIN) { E.fused(acc, cur, wr, wc, fr, fq, lds, wid, lane); S.done(cur); }
#undef PG8_SA
#undef PG8_SB
#undef PG8_STAGE
#undef PG8_LDA
#undef PG8_LDB
#undef PG8_MMA
#undef PG8_WAIT_V
#undef PG8_WAIT_L
#undef PG8_BAR
#undef PG8_SCHED
}
}
namespace att {
using bf16 = unsigned short;
constexpr int   D = 128, NW = 8, QBLK = 32, KVBLK = 64;
constexpr float SCALE = 0.088388347648318440f;
constexpr float THR = 8.f;
constexpr int SDEPTH = 2;
constexpr size_t SHM_V = KVBLK * D * 2, SHM_K = KVBLK * D * 2, SHM_ATTN = 2 * SHM_V + 2 * SHM_K + NW * 64 * 4;
using bf16x8 = __attribute__((ext_vector_type(8))) short;
using s16x4  = __attribute__((ext_vector_type(4))) short;
using f32x16 = __attribute__((ext_vector_type(16))) float;
using f32x8  = __attribute__((ext_vector_type(8))) float;
using u32x4  = __attribute__((ext_vector_type(4))) unsigned;
#define KSWZ(row, colB) ((row) * 256 + ((colB) ^ (((row) & 7) << 4)))
#define SBAR() __builtin_amdgcn_sched_barrier(0)
__device__ __forceinline__ int crow(int r, int hi) { return (r & 3) + 8 * (r >> 2) + 4 * hi; }
__device__ __forceinline__ unsigned cvtpk(float lo, float hi) {
  unsigned r; asm volatile("v_cvt_pk_bf16_f32 %0, %1, %2" : "=v"(r) : "v"(lo), "v"(hi)); return r;
}
struct St { using T = bf16x8;
  __device__ static __forceinline__ T ld8(const bf16* p) { return *reinterpret_cast<const bf16x8*>(p); }
  __device__ static __forceinline__ bf16x8 tobf(T x) { return x; } };
__device__ __forceinline__ void partialSM(f32x16& p0, f32x16& p1, float& m_reg, float& mn, float& alpha) {
  constexpr float C = SCALE * 1.4426950408889634f;
  float pmax = p0[0]; for (int r = 1; r < 16; ++r) pmax = fmaxf(pmax, p0[r]); for (int r = 0; r < 16; ++r) pmax = fmaxf(pmax, p1[r]);
  { auto rr = __builtin_amdgcn_permlane32_swap(__float_as_uint(pmax), __float_as_uint(pmax), false, false);
    pmax = fmaxf(__uint_as_float(rr[0]), __uint_as_float(rr[1])); }
  if (__builtin_expect(__all(pmax - m_reg <= THR / SCALE), 1)) { mn = m_reg; alpha = 1.f; }
  else { mn = fmaxf(m_reg, pmax); alpha = __builtin_amdgcn_exp2f((m_reg - mn) * C); m_reg = mn; }
  float mnC = -mn * C;
  for (int r = 0; r < 16; ++r) p0[r] = fmaf(p0[r], C, mnC); for (int r = 0; r < 16; ++r) p1[r] = fmaf(p1[r], C, mnC);
  for (int r = 0; r < 16; ++r) p0[r] = __builtin_amdgcn_exp2f(p0[r]);
}
__device__ __forceinline__ void finishSM(f32x16& p0, f32x16& p1, float alpha, float& l_reg, bf16x8& pa0, bf16x8& pa1, bf16x8& pa2, bf16x8& pa3) {
  for (int r = 0; r < 16; ++r) p1[r] = __builtin_amdgcn_exp2f(p1[r]);
  float ps = 0; for (int r = 0; r < 16; ++r) ps += p0[r]; for (int r = 0; r < 16; ++r) ps += p1[r];
  { auto rr = __builtin_amdgcn_permlane32_swap(__float_as_uint(ps), __float_as_uint(ps), false, false);
    ps = __uint_as_float(rr[0]) + __uint_as_float(rr[1]); }
  l_reg = l_reg * alpha + ps;
#define PK4(P, BASE, OUT) do { unsigned a0 = cvtpk(P[BASE + 0], P[BASE + 1]), a1 = cvtpk(P[BASE + 2], P[BASE + 3]);   \
    unsigned b0 = cvtpk(P[BASE + 4], P[BASE + 5]), b1 = cvtpk(P[BASE + 6], P[BASE + 7]);                              \
    auto r0 = __builtin_amdgcn_permlane32_swap(a0, b0, false, false); auto r1 = __builtin_amdgcn_permlane32_swap(a1, b1, false, false); \
    u32x4 w = {r0[0], r1[0], r0[1], r1[1]}; OUT = *reinterpret_cast<bf16x8*>(&w); } while (0)
  PK4(p0, 0, pa0); PK4(p0, 8, pa1); PK4(p1, 0, pa2); PK4(p1, 8, pa3);
#undef PK4
}
__device__ __forceinline__ void qkt(f32x16& p0, f32x16& p1, const bf16* Ks, const bf16x8* qr, int r32, int hi) {
  p0 = f32x16{}; p1 = f32x16{};
  for (int d0 = 0; d0 < 8; ++d0) { int cb = (d0 * 16 + hi * 8) * 2;
    bf16x8 b0 = *reinterpret_cast<const bf16x8*>((const char*)Ks + KSWZ(r32, cb));
    bf16x8 b1 = *reinterpret_cast<const bf16x8*>((const char*)Ks + KSWZ(32 + r32, cb));
    p0 = __builtin_amdgcn_mfma_f32_32x32x16_bf16(b0, qr[d0], p0, 0, 0, 0);
    p1 = __builtin_amdgcn_mfma_f32_32x32x16_bf16(b1, qr[d0], p1, 0, 0, 0); }
}
__device__ __forceinline__ int v_st(int k, int c) { const int kk = (k & ~0xC) | ((k & 4) << 1) | ((k & 8) >> 1); return ((kk >> 3) * 4 + (c >> 5)) * 512 + ((kk & 7) * 32 + (c & 31)) * 2; }
__device__ __forceinline__ int v_rd_base(int lane) { return ((lane & 3) << 3) | (((lane >> 2) & 3) << 6) | (((lane >> 4) & 1) << 5) | (((lane >> 5) & 1) << 8); }
constexpr int v_rd_off(int d0, int ks, int half) { return d0 * 512 + ks * 4096 + half * 2048; }
template <int OFF> __device__ __forceinline__ s16x4 tr_read(int vb) {
  s16x4 r; asm volatile("ds_read_b64_tr_b16 %0, %1 offset:%2" : "=&v"(r) : "v"(vb), "i"(OFF) : "memory"); return r;
}
template <int D0> __device__ __forceinline__ void pv_one(f32x16& od, int vb, bf16x8 pa0, bf16x8 pa1, bf16x8 pa2, bf16x8 pa3) {
  const s16x4 l0 = tr_read<v_rd_off(D0, 0, 0)>(vb), h0 = tr_read<v_rd_off(D0, 0, 1)>(vb), l1 = tr_read<v_rd_off(D0, 1, 0)>(vb), h1 = tr_read<v_rd_off(D0, 1, 1)>(vb);
  const s16x4 l2 = tr_read<v_rd_off(D0, 2, 0)>(vb), h2 = tr_read<v_rd_off(D0, 2, 1)>(vb), l3 = tr_read<v_rd_off(D0, 3, 0)>(vb), h3 = tr_read<v_rd_off(D0, 3, 1)>(vb);
  asm volatile("s_waitcnt lgkmcnt(0)" ::: "memory"); SBAR();
#define PK(L, H) (bf16x8){L[0], L[1], L[2], L[3], H[0], H[1], H[2], H[3]}
  od = __builtin_amdgcn_mfma_f32_32x32x16_bf16(pa0, PK(l0, h0), od, 0, 0, 0);
  od = __builtin_amdgcn_mfma_f32_32x32x16_bf16(pa1, PK(l1, h1), od, 0, 0, 0);
  od = __builtin_amdgcn_mfma_f32_32x32x16_bf16(pa2, PK(l2, h2), od, 0, 0, 0);
  od = __builtin_amdgcn_mfma_f32_32x32x16_bf16(pa3, PK(l3, h3), od, 0, 0, 0);
#undef PK
}
__device__ __forceinline__ void pv_d0(f32x16* o, int vb, bf16x8 pa0, bf16x8 pa1, bf16x8 pa2, bf16x8 pa3) {
  pv_one<0>(o[0], vb, pa0, pa1, pa2, pa3); pv_one<1>(o[1], vb, pa0, pa1, pa2, pa3); pv_one<2>(o[2], vb, pa0, pa1, pa2, pa3); pv_one<3>(o[3], vb, pa0, pa1, pa2, pa3);
}
template <int LDQ, int LDK, int LDO>
__device__ __forceinline__ void attn_dense_body(const bf16* __restrict__ Qb, const bf16* __restrict__ Kh, const bf16* __restrict__ Vh,
                                                bf16* __restrict__ Ob, int seq, char* lds) {
  const int tid = ::opaque_tid(), wid = tid >> 6, lane = tid & 63, r32 = lane & 31, hi = lane >> 5;
  bf16* V_lds = (bf16*)lds; bf16* K_lds = (bf16*)(lds + 2 * SHM_V);
  float* ws = (float*)(lds + 2 * SHM_V + 2 * SHM_K) + wid * 64; float* li_l = ws; float* al_l = ws + 32;
  float m_reg = -1e30f, l_reg = 0; f32x16 o[4] = {}; bf16x8 qr[8];
  const bf16* Qw = Qb + (long)(wid * QBLK + r32) * LDQ + hi * 8;
#pragma unroll
  for (int d0 = 0; d0 < 8; ++d0) qr[d0] = St::ld8(Qw + d0 * 16);
  const int sr = tid >> 4, sc = (tid & 15) * 8, vst0 = v_st(sr, sc), vst1 = v_st(32 + sr, sc);
  const int vb0 = (int)(uintptr_t)V_lds + v_rd_base(lane);
  struct { typename St::T vs0, vs1, ks0, ks1; } sr_[1];
#define SLOAD(i, k0) do { sr_[i].vs0 = St::ld8(&Vh[(long)((k0) + sr) * LDK + sc]); sr_[i].vs1 = St::ld8(&Vh[(long)((k0) + 32 + sr) * LDK + sc]); \
    sr_[i].ks0 = St::ld8(&Kh[(long)((k0) + sr) * LDK + sc]); sr_[i].ks1 = St::ld8(&Kh[(long)((k0) + 32 + sr) * LDK + sc]); } while (0)
#define SWRITE(b, i) do { *(bf16x8*)((char*)V_lds + (b) * SHM_V + vst0) = St::tobf(sr_[i].vs0);          \
    *(bf16x8*)((char*)V_lds + (b) * SHM_V + vst1) = St::tobf(sr_[i].vs1); int kc = sc * 2;               \
    *(bf16x8*)((char*)K_lds + (b) * SHM_K + KSWZ(sr, kc)) = St::tobf(sr_[i].ks0);                       \
    *(bf16x8*)((char*)K_lds + (b) * SHM_K + KSWZ(32 + sr, kc)) = St::tobf(sr_[i].ks1); } while (0)
#define SWAIT() do { asm volatile("s_waitcnt vmcnt(0)" ::: "memory"); } while (0)
#define RESC(a) do { if (__any((a) < 1.f)) { if (hi == 0) al_l[r32] = (a); asm volatile("s_waitcnt lgkmcnt(0)" ::: "memory"); \
    for (int d = 0; d < 4; ++d) for (int r = 0; r < 16; ++r) o[d][r] *= al_l[crow(r, hi)]; } } while (0)
  f32x16 pA0, pA1, pB0, pB1; float mnA, mnB, alA, alB; bf16x8 pa0, pa1, pa2, pa3; const int NT = seq / KVBLK;
  constexpr int SE = 0, SO = 0;
  SLOAD(SE, 0); asm volatile("s_waitcnt vmcnt(0)" ::: "memory"); SWRITE(0, SE); __syncthreads();
  qkt(pA0, pA1, K_lds, qr, r32, hi); partialSM(pA0, pA1, m_reg, mnA, alA);
  SLOAD(SO, KVBLK);
  SWAIT(); SWRITE(1, SO); __syncthreads();
  for (int j = 1; j + 1 < NT; j += 2) {
    SBAR(); qkt(pB0, pB1, (bf16*)((char*)K_lds + SHM_K), qr, r32, hi);
    finishSM(pA0, pA1, alA, l_reg, pa0, pa1, pa2, pa3); SBAR();
    SLOAD(SO, (j + 1) * KVBLK); SBAR();
    pv_d0(o, vb0, pa0, pa1, pa2, pa3); partialSM(pB0, pB1, m_reg, mnB, alB);
    __syncthreads(); SWAIT(); SWRITE(0, SE);
    RESC(alB); __syncthreads();
    SBAR(); qkt(pA0, pA1, K_lds, qr, r32, hi);
    finishSM(pB0, pB1, alB, l_reg, pa0, pa1, pa2, pa3); SBAR();
    SLOAD(SE, (j + 2) * KVBLK); SBAR();
    pv_d0(o, vb0 + (int)SHM_V, pa0, pa1, pa2, pa3); partialSM(pA0, pA1, m_reg, mnA, alA);
    __syncthreads(); SWAIT(); SWRITE(1, SO);
    RESC(alA); __syncthreads();
  }
  SBAR(); qkt(pB0, pB1, (bf16*)((char*)K_lds + SHM_K), qr, r32, hi);
  finishSM(pA0, pA1, alA, l_reg, pa0, pa1, pa2, pa3); SBAR();
  pv_d0(o, vb0, pa0, pa1, pa2, pa3); partialSM(pB0, pB1, m_reg, mnB, alB);
  __syncthreads(); RESC(alB);
  finishSM(pB0, pB1, alB, l_reg, pa0, pa1, pa2, pa3); SBAR();
  pv_d0(o, vb0 + (int)SHM_V, pa0, pa1, pa2, pa3);
  if (hi == 0) li_l[r32] = l_reg; asm volatile("s_waitcnt lgkmcnt(0)" ::: "memory");
  float rli[16];
#pragma unroll
  for (int r = 0; r < 16; ++r) rli[r] = __builtin_amdgcn_rcpf(li_l[crow(r, hi)]);
  bf16* Ow = Ob + (long)(wid * QBLK) * LDO;
#pragma unroll
  for (int r = 0; r < 16; ++r) { int orow = crow(r, hi);
#pragma unroll
    for (int d0 = 0; d0 < 4; ++d0) Ow[(long)orow * LDO + d0 * 32 + r32] = (bf16)(cvtpk(o[d0][r] * rli[r], 0.f) & 0xffffu); }
  __syncthreads();
}

__device__ __forceinline__ void packP(const f32x16& p0, const f32x16& p1, bf16x8& pa0, bf16x8& pa1, bf16x8& pa2, bf16x8& pa3) {
#define PK4(P, BASE, OUT) do { unsigned a0 = cvtpk(P[BASE + 0], P[BASE + 1]), a1 = cvtpk(P[BASE + 2], P[BASE + 3]);   \
    unsigned b0 = cvtpk(P[BASE + 4], P[BASE + 5]), b1 = cvtpk(P[BASE + 6], P[BASE + 7]);                              \
    auto r0 = __builtin_amdgcn_permlane32_swap(a0, b0, false, false); auto r1 = __builtin_amdgcn_permlane32_swap(a1, b1, false, false); \
    u32x4 w = {r0[0], r1[0], r0[1], r1[1]}; OUT = *reinterpret_cast<bf16x8*>(&w); } while (0)
  PK4(p0, 0, pa0); PK4(p0, 8, pa1); PK4(p1, 0, pa2); PK4(p1, 8, pa3);
#undef PK4
}
template <int MODE>
__device__ __forceinline__ void ret_weight(f32x16& p0, f32x16& p1, int jt, int nst, int n, int L, float lgf, float lgb, int hi) {
  constexpr float LS = -3.5f;
  if (MODE == 0 && jt < nst) {
    const float w = (jt < 2) ? __builtin_amdgcn_exp2f(lgf * (float)(n + 1)) : __builtin_amdgcn_exp2f(lgb * (float)(L - n));
#pragma unroll
    for (int r = 0; r < 16; ++r) { p0[r] *= w; p1[r] *= w; }
  } else if (MODE == 0) {
    const float fd0 = (float)(n - (jt - nst) * 64 - 4 * hi);
    const float nlgb = -lgb;
#pragma unroll
    for (int r = 0; r < 16; ++r) {
#pragma unroll
      for (int half = 0; half < 2; ++half) {
        const float d = fd0 - (float)((r & 3) + 8 * (r >> 2) + 32 * half);
        float e = fminf(fmaf(lgf, d, LS), fmaf(nlgb, d, LS)); e = (d == 0.f) ? LS + 1.f : e;
        const float w = __builtin_amdgcn_exp2f(e);
        if (half == 0) p0[r] *= w; else p1[r] *= w;
      }
    }
  } else {
    const float fm0 = (float)(jt * 64 + 4 * hi); const bool bwd = n >= 128; const float c0 = bwd ? LS : fmaf(lgf, (float)(L - 1), LS), sl = bwd ? lgb : -lgf;
#pragma unroll
    for (int r = 0; r < 16; ++r) {
#pragma unroll
      for (int half = 0; half < 2; ++half) {
        const float m = fm0 + (float)((r & 3) + 8 * (r >> 2) + 32 * half);
        const float w = __builtin_amdgcn_exp2f(fmaf(sl, m, c0));
        if (half == 0) p0[r] *= w; else p1[r] *= w;
      }
    }
  }
}
#define SWAIT0() do { asm volatile("s_waitcnt vmcnt(0)" ::: "memory"); } while (0)
template <int MODE, int LDQ>
__device__ __forceinline__ void retn_body(const bf16* __restrict__ Qb, const bf16* __restrict__ Kh, const bf16* __restrict__ Vh, int seq, int nst, int nq0, int L,
                                          float lgf, float lgb, const bf16* __restrict__ Gb, bf16* __restrict__ Ob, float* __restrict__ So, char* lds) {
  constexpr int LDK = 128;
  const int tid = ::opaque_tid(), wid = tid >> 6, lane = tid & 63, r32 = lane & 31, hi = lane >> 5;
  bf16* V_lds = (bf16*)lds; bf16* K_lds = (bf16*)(lds + 2 * SHM_V);
  f32x16 o[4] = {}; bf16x8 qr[8];
  const bf16* Qw = Qb + (long)(wid * QBLK + r32) * LDQ + hi * 8;
#pragma unroll
  for (int d0 = 0; d0 < 8; ++d0) qr[d0] = St::ld8(Qw + d0 * 16);
  const int nq = nq0 + wid * QBLK + r32;
  const int sr = tid >> 4, sc = (tid & 15) * 8, vst0 = v_st(sr, sc), vst1 = v_st(32 + sr, sc);
  const int vb0 = (int)(uintptr_t)V_lds + v_rd_base(lane);
  struct { typename St::T vs0, vs1, ks0, ks1; } sr_[1];
  f32x16 pA0, pA1, pB0, pB1; bf16x8 pa0, pa1, pa2, pa3; const int NT = seq / KVBLK;
  constexpr int SE = 0, SO = 0;
  SLOAD(SE, 0); asm volatile("s_waitcnt vmcnt(0)" ::: "memory"); SWRITE(0, SE); __syncthreads();
  qkt(pA0, pA1, K_lds, qr, r32, hi); ret_weight<MODE>(pA0, pA1, 0, nst, nq, L, lgf, lgb, hi);
  SLOAD(SO, KVBLK);
  SWAIT0(); SWRITE(1, SO); __syncthreads();
  for (int j = 1; j + 1 < NT; j += 2) {
    SBAR(); qkt(pB0, pB1, (bf16*)((char*)K_lds + SHM_K), qr, r32, hi);
    packP(pA0, pA1, pa0, pa1, pa2, pa3); SBAR();
    SLOAD(SO, (j + 1) * KVBLK); SBAR();
    pv_d0(o, vb0, pa0, pa1, pa2, pa3); ret_weight<MODE>(pB0, pB1, j, nst, nq, L, lgf, lgb, hi);
    __syncthreads(); SWAIT0(); SWRITE(0, SE);
    __syncthreads();
    SBAR(); qkt(pA0, pA1, K_lds, qr, r32, hi);
    packP(pB0, pB1, pa0, pa1, pa2, pa3); SBAR();
    SLOAD(SE, (j + 2) * KVBLK); SBAR();
    pv_d0(o, vb0 + (int)SHM_V, pa0, pa1, pa2, pa3); ret_weight<MODE>(pA0, pA1, j + 1, nst, nq, L, lgf, lgb, hi);
    __syncthreads(); SWAIT0(); SWRITE(1, SO);
    __syncthreads();
  }
  SBAR(); qkt(pB0, pB1, (bf16*)((char*)K_lds + SHM_K), qr, r32, hi);
  packP(pA0, pA1, pa0, pa1, pa2, pa3); SBAR();
  pv_d0(o, vb0, pa0, pa1, pa2, pa3); ret_weight<MODE>(pB0, pB1, NT - 1, nst, nq, L, lgf, lgb, hi);
  __syncthreads();
  packP(pB0, pB1, pa0, pa1, pa2, pa3); SBAR();
  pv_d0(o, vb0 + (int)SHM_V, pa0, pa1, pa2, pa3);
  if (MODE == 1) {
#pragma unroll
    for (int r = 0; r < 16; ++r) { const int n = wid * QBLK + crow(r, hi); float* rowp = So + (size_t)(n >> 7) * 65536 + (size_t)(n & 127) * 128;
#pragma unroll
      for (int d0 = 0; d0 < 4; ++d0) rowp[d0 * 32 + r32] = o[d0][r]; }
  } else {
    bf16 graw[16][4];
#pragma unroll
    for (int r = 0; r < 16; ++r) { const int orow = wid * QBLK + crow(r, hi);
#pragma unroll
      for (int d0 = 0; d0 < 4; ++d0) graw[r][d0] = Gb[(long)orow * LDQ + d0 * 32 + r32]; }
#pragma unroll
    for (int r = 0; r < 16; ++r) { const int orow = wid * QBLK + crow(r, hi);
      float s = (o[0][r] + o[1][r]) + (o[2][r] + o[3][r]);
#pragma unroll
      for (int x = 1; x < 32; x <<= 1) s += __shfl_xor(s, x);
      const float mean = s * (1.f / 128.f);
      const float d0v = o[0][r] - mean, d1v = o[1][r] - mean, d2v = o[2][r] - mean, d3v = o[3][r] - mean;
      float q = (d0v * d0v + d1v * d1v) + (d2v * d2v + d3v * d3v);
#pragma unroll
      for (int x = 1; x < 32; x <<= 1) q += __shfl_xor(q, x);
      const float rstd = 1.0f / sqrtf(q * (1.f / 128.f) + 1e-6f);
      const float dv[4] = {d0v, d1v, d2v, d3v};
#pragma unroll
      for (int d0 = 0; d0 < 4; ++d0) { const float g = __uint_as_float(((unsigned)graw[r][d0]) << 16);
        const float sg = g * __builtin_amdgcn_rcpf(1.f + __expf(-g));
        Ob[(long)orow * 2048 + d0 * 32 + r32] = (bf16)(cvtpk(sg * dv[d0] * rstd, 0.f) & 0xffffu); }
    }
  }
  __syncthreads();
}
#undef SLOAD
#undef SWRITE
#undef SWAIT
#undef SWAIT0
#undef RESC
}
#define LAS __attribute__((address_space(3)))
typedef unsigned short bf16_t;
typedef float f32x4 __attribute__((ext_vector_type(4)));
typedef float f32x2 __attribute__((ext_vector_type(2)));
typedef unsigned u32x4 __attribute__((ext_vector_type(4)));
typedef unsigned u32x2 __attribute__((ext_vector_type(2)));
typedef short bf16x8 __attribute__((ext_vector_type(8)));
constexpr int DM = 2048, MROWS = 12288, MCTX = 4096, NIN = 5120, DFF = 5632, NUP = 11264;
constexpr size_t MiB = (size_t)1 << 20;
constexpr size_t WS_CTL = 0, WS_MOD = 1 * MiB, WS_GF0 = 2 * MiB, WS_GF1 = 3 * MiB, WS_IDQ = 7 * MiB;
constexpr size_t WS_WIN = 10 * MiB, WS_WOUT = 30 * MiB, WS_WUP = 38 * MiB, WS_WDN = 82 * MiB, WS_H = 104 * MiB, WS_OV = 152 * MiB;
constexpr size_t WS_PROJ = WS_OV, WS_CONCAT = WS_OV + 120 * MiB, WS_QN = WS_OV + 168 * MiB, WS_KBL = WS_OV + 192 * MiB, WS_VBL = WS_OV + 198 * MiB,
                 WS_KBC = WS_OV + 204 * MiB, WS_VBC = WS_OV + 206 * MiB, WS_KEL = WS_OV + 208 * MiB, WS_VEL = WS_OV + 218 * MiB, WS_KEC = WS_OV + 228 * MiB,
                 WS_VEC = WS_OV + 232 * MiB, WS_HYT = WS_OV + 236 * MiB;
constexpr size_t WS_STASH = WS_OV;
constexpr size_t WS_UP = WS_OV, WS_ACT = WS_OV + 264 * MiB, WS_W1SET = WS_OV + 396 * MiB, WS_YB = WS_W1SET + 94 * MiB, WS_END = WS_YB + 48 * MiB + 8 * MiB;
__device__ __forceinline__ size_t wofs(int l) { return l ? (WS_W1SET - WS_WIN) : 0; }
constexpr size_t WS_STATS1 = WS_CTL + 131072, WS_STATS2 = WS_CTL + 262144;
constexpr size_t GF_LSTRIDE = WS_YB + 48 * MiB - WS_GF0;
constexpr int LDS_BYTES = 147456, LDS_ITEM_OFF = LDS_BYTES - 64;
constexpr size_t OUT_CK = 25165824, OUT_CV = 27262976, OUT_ST = 29360128;

struct Params { const float* in[29]; float* out; unsigned char* ws; unsigned long long pad; };
typedef const __attribute__((address_space(4))) Params* KP;
__device__ __forceinline__ KP kp_fresh() { KP k = (KP)__builtin_amdgcn_kernarg_segment_ptr(); asm volatile("" : "+s"(k)); return k; }
enum { I_XP = 0, I_XS, I_CK, I_CV, I_ST, I_C, I_CCTX, I_WADA, I_BADA, I_WIN, I_QN, I_KN, I_RDEC, I_HYCONV, I_HW1, I_HB1, I_HFREQ, I_HW2, I_HB2, I_HW3, I_HYBIAS, I_WOUT,
       I_LN1W, I_LN1B, I_WUP, I_FFNCONV, I_WDN, I_LN2W, I_LN2B };

__device__ __forceinline__ unsigned f2bf(float f) { unsigned u = __builtin_bit_cast(unsigned, f); return (u + 0x7fffu + ((u >> 16) & 1u)) >> 16; }
__device__ __forceinline__ unsigned pk2(float lo, float hi) { return f2bf(lo) | (f2bf(hi) << 16); }
__device__ __forceinline__ float bf2f(unsigned short b) { return __uint_as_float(((unsigned)b) << 16); }
__device__ __forceinline__ float bflo(unsigned w) { return __uint_as_float(w << 16); }
__device__ __forceinline__ float bfhi(unsigned w) { return __uint_as_float(w & 0xffff0000u); }
__device__ __forceinline__ float wave_sum(float v) {
#pragma unroll
    for (int o = 1; o < 64; o <<= 1) v += __shfl_xor(v, o);
    return v;
}
__device__ __forceinline__ float silu_f(float x) { return x * __builtin_amdgcn_rcpf(1.f + __expf(-x)); }

__device__ __forceinline__ void transpose_tile(const float* __restrict__ W, int K, int N, bf16_t* __restrict__ WT, LAS float* scr, int tile, int lane) {
    const int nblk = N >> 6, kb = tile / nblk, nb = tile - kb * nblk, k0 = kb * 64, n0 = nb * 64;
    float v[64];
    const float* src = W + (size_t)k0 * N + n0 + lane;
#pragma unroll
    for (int i = 0; i < 64; ++i) v[i] = src[(size_t)i * N];
#pragma unroll
    for (int i = 0; i < 64; ++i) scr[i * 65 + lane] = v[i];
    asm volatile("s_waitcnt lgkmcnt(0)" ::: "memory");
    const int c = lane & 7;
#pragma unroll
    for (int j = 0; j < 8; ++j) { const int n = (lane >> 3) + 8 * j; const LAS float* s = scr + (8 * c) * 65 + n;
        u32x4 o; o.x = pk2(s[0 * 65], s[1 * 65]); o.y = pk2(s[2 * 65], s[3 * 65]); o.z = pk2(s[4 * 65], s[5 * 65]); o.w = pk2(s[6 * 65], s[7 * 65]);
        *(u32x4*)(WT + (size_t)(n0 + n) * K + k0 + 8 * c) = o; }
    asm volatile("s_waitcnt lgkmcnt(0)" ::: "memory");
}
__device__ __forceinline__ void transpose_tile_up(const float* __restrict__ W, bf16_t* __restrict__ WT, LAS float* scr, int tile, int lane) {
    constexpr int K = DM, N = NUP;
    const int nblk = N >> 6, kb = tile / nblk, nb = tile - kb * nblk, k0 = kb * 64, n0 = nb * 64;
    const int n0p = n0 < DFF ? 256 * (n0 >> 7) + (n0 & 127) : 256 * ((n0 - DFF) >> 7) + 128 + ((n0 - DFF) & 127);
    float v[64];
    const float* src = W + (size_t)k0 * N + n0 + lane;
#pragma unroll
    for (int i = 0; i < 64; ++i) v[i] = src[(size_t)i * N];
#pragma unroll
    for (int i = 0; i < 64; ++i) scr[i * 65 + lane] = v[i];
    asm volatile("s_waitcnt lgkmcnt(0)" ::: "memory");
    const int c = lane & 7;
#pragma unroll
    for (int j = 0; j < 8; ++j) { const int n = (lane >> 3) + 8 * j; const LAS float* s = scr + (8 * c) * 65 + n;
        u32x4 o; o.x = pk2(s[0 * 65], s[1 * 65]); o.y = pk2(s[2 * 65], s[3 * 65]); o.z = pk2(s[4 * 65], s[5 * 65]); o.w = pk2(s[6 * 65], s[7 * 65]);
        *(u32x4*)(WT + (size_t)(n0p + n) * K + k0 + 8 * c) = o; }
    asm volatile("s_waitcnt lgkmcnt(0)" ::: "memory");
}
constexpr int T_IN = 32 * 80, T_OUT = 32 * 32, T_UP = 32 * 176, T_DN = 88 * 32, T_ALL = T_IN + T_OUT + T_UP + T_DN;
__device__ __forceinline__ void convert_tile(KP p, LAS float* scr, int l, int it, int lane) {
    int r = it; const size_t wo = wofs(l);
    if (r < T_IN) { transpose_tile(p->in[I_WIN] + (size_t)l * DM * NIN, DM, NIN, (bf16_t*)(p->ws + WS_WIN + wo), scr, r, lane); return; } r -= T_IN;
    if (r < T_OUT) { transpose_tile(p->in[I_WOUT] + (size_t)l * DM * DM, DM, DM, (bf16_t*)(p->ws + WS_WOUT + wo), scr, r, lane); return; } r -= T_OUT;
    if (r < T_UP) { transpose_tile_up(p->in[I_WUP] + (size_t)l * DM * NUP, (bf16_t*)(p->ws + WS_WUP + wo), scr, r, lane); return; } r -= T_UP;
    if (r < T_DN) transpose_tile(p->in[I_WDN] + (size_t)l * DFF * DM, DFF, DM, (bf16_t*)(p->ws + WS_WDN + wo), scr, r, lane);
}
__device__ __forceinline__ void convert_weights(KP p, LAS unsigned char* lds, int l, int lo, int hi) {
    const int tid = opaque_tid(), wave = tid >> 6, lane = tid & 63;
    LAS float* scr = (LAS float*)lds + wave * (64 * 65);
    const int gw = blockIdx.x * 8 + wave, NGW = gridDim.x * 8;
    for (int it = lo + gw; it < hi; it += NGW) convert_tile(p, scr, l, it, lane);
}
__device__ __forceinline__ void convert_block_item(KP p, LAS unsigned char* lds, int l, int tile0) {
    const int tid = opaque_tid(), wave = tid >> 6, lane = tid & 63;
    convert_tile(p, (LAS float*)lds + wave * (64 * 65), l, tile0 + wave, lane);
}
__device__ __forceinline__ void adaln_item(KP p, LAS unsigned char* lds, int item) {
    LAS float* scond = (LAS float*)lds;
    LAS float* red = (LAS float*)(lds + 98304);
    const int tid = opaque_tid(), w = tid >> 6, lane = tid & 63;
    { float cv[4][9];
#pragma unroll
      for (int kk = 0; kk < 4; ++kk) { const int k = tid + 512 * kk; cv[kk][0] = p->in[I_CCTX][k];
#pragma unroll
          for (int r = 1; r < 9; ++r) cv[kk][r] = p->in[I_C][(r - 1) * 2048 + k]; }
#pragma unroll
      for (int kk = 0; kk < 4; ++kk) { const int k = tid + 512 * kk;
#pragma unroll
          for (int r = 0; r < 9; ++r) scond[k * 12 + r] = silu_f(cv[kk][r]); } }
    __syncthreads();
    float* mod = (float*)(p->ws + WS_MOD);
    {
        const int l = item / 96, jj = item - l * 96, j = jj >> 1, kh = jj & 1;
        const float* W = p->in[I_WADA] + (size_t)l * 2048 * 12288 + j * 256 + lane * 4;
        f32x4 acc[9];
#pragma unroll
        for (int r = 0; r < 9; ++r) acc[r] = (f32x4){0.f, 0.f, 0.f, 0.f};
        const int k0 = kh * 1024 + w * 128;
#pragma unroll 8
        for (int k = k0; k < k0 + 128; ++k) {
            const f32x4 wv = *(const f32x4*)(W + (size_t)k * 12288);
            const f32x4 s0 = *(const LAS f32x4*)(scond + k * 12), s1 = *(const LAS f32x4*)(scond + k * 12 + 4), s2 = *(const LAS f32x4*)(scond + k * 12 + 8);
            acc[0] += wv * s0[0]; acc[1] += wv * s0[1]; acc[2] += wv * s0[2]; acc[3] += wv * s0[3];
            acc[4] += wv * s1[0]; acc[5] += wv * s1[1]; acc[6] += wv * s1[2]; acc[7] += wv * s1[3]; acc[8] += wv * s2[0];
        }
#pragma unroll
        for (int half = 0; half < 2; ++half) {
            __syncthreads();
#pragma unroll
            for (int q = 0; q < 18; ++q) { const int qq = half * 18 + q; red[(w * 18 + q) * 64 + lane] = acc[qq >> 2][qq & 3]; }
            __syncthreads();
            for (int idx = tid; idx < 18 * 64; idx += 512) { const int q = idx >> 6, ln = idx & 63; float s = 0.f;
#pragma unroll
                for (int ww = 0; ww < 8; ++ww) s += red[(ww * 18 + q) * 64 + ln];
                const int qq = half * 18 + q, r = qq >> 2, col = j * 256 + ln * 4 + (qq & 3);
                if (kh == 0) s += p->in[I_BADA][l * 12288 + col];
                atomicAdd(mod + (size_t)(l * 9 + r) * 12288 + col, s); }
        }
        __syncthreads();
    }
}
__device__ __forceinline__ void filter_items(KP p, LAS unsigned char* lds, int l, int item_lo, int item_hi, int item_step) {
    LAS float* zb = (LAS float*)lds;
    LAS float* h1 = zb + 8 * 36;
    LAS float* h2 = h1 + 8 * 64;
    LAS float* W1s = h2 + 8 * 64;
    LAS float* W2s = W1s + 33 * 64;
    const int tid = opaque_tid();
    const float* w1 = p->in[I_HW1] + l * 33 * 64; const float* b1 = p->in[I_HB1] + l * 64; const float* fr = p->in[I_HFREQ] + l * 64;
    const float* w2 = p->in[I_HW2] + l * 64 * 64; const float* b2 = p->in[I_HB2] + l * 64; const float* w3 = p->in[I_HW3] + (size_t)l * 64 * 2048;
    { float t1[5], t2[8];
#pragma unroll
      for (int k = 0; k < 5; ++k) t1[k] = (tid + 512 * k < 33 * 64) ? w1[tid + 512 * k] : 0.f;
#pragma unroll
      for (int k = 0; k < 8; ++k) t2[k] = w2[tid + 512 * k];
#pragma unroll
      for (int k = 0; k < 5; ++k) if (tid + 512 * k < 33 * 64) W1s[tid + 512 * k] = t1[k];
#pragma unroll
      for (int k = 0; k < 8; ++k) W2s[tid + 512 * k] = t2[k]; }
    __syncthreads();
    for (int item = item_lo; item < item_hi; item += item_step) {
        const int g = item < 32 ? 0 : 1, tb = g ? item - 32 : item, L = g ? 1024 : 256;
        bf16_t* GF = (bf16_t*)(p->ws + (g ? WS_GF1 : WS_GF0) + (size_t)l * GF_LSTRIDE);
        if (tid < 8 * 33) { const int tl = tid / 33, i = tid - tl * 33; const int t = tb * 8 + tl; float z;
            if (i == 0) z = (float)t / (float)(L - 1);
            else { const int fi = (i - 1) & 15; const float f = 1e-4f + (float)fi * ((15.0f - 1e-4f) / 15.0f); const float ang = (6.283185307179586f * (float)t / (float)L) * f;
                z = (i <= 16) ? cosf(ang) : -sinf(ang); }
            zb[tl * 36 + i] = z; }
        __syncthreads();
        { const int tl = tid >> 6, j = tid & 63; float s = b1[j];
#pragma unroll 11
          for (int i = 0; i < 33; ++i) s += zb[tl * 36 + i] * W1s[i * 64 + j];
          h1[tl * 64 + j] = sinf(fr[j] * s); }
        __syncthreads();
        { const int tl = tid >> 6, j = tid & 63; float s = b2[j];
#pragma unroll 8
          for (int i = 0; i < 64; ++i) s += h1[tl * 64 + i] * W2s[i * 64 + j];
          h2[tl * 64 + j] = sinf(fr[j] * s); }
        __syncthreads();
        { const int q0 = tid * 4; const int o = q0 >> 10, dir = (q0 >> 9) & 1, c0 = q0 & 511;
            f32x4 acc[8];
#pragma unroll
            for (int tl = 0; tl < 8; ++tl) acc[tl] = (f32x4){0.f, 0.f, 0.f, 0.f};
#pragma unroll 1
            for (int i0 = 0; i0 < 64; i0 += 16) { f32x4 wv[16];
#pragma unroll
                for (int ii = 0; ii < 16; ++ii) wv[ii] = *(const f32x4*)(w3 + (size_t)(i0 + ii) * 2048 + q0);
#pragma unroll
                for (int ii = 0; ii < 16; ++ii)
#pragma unroll
                    for (int tl = 0; tl < 8; ++tl) acc[tl] += wv[ii] * h2[tl * 64 + i0 + ii]; }
            const float a = -15.350567286626973f, b = -3.0701134573253945f;
#pragma unroll
            for (int e = 0; e < 4; ++e) { const int c = c0 + e; const float delta = fabsf(a + (float)c * ((b - a) / 511.0f));
                bf16_t* Gc = GF + ((size_t)o * 512 + c) * (2 * L);
#pragma unroll
                for (int tl = 0; tl < 8; ++tl) { const int t = tb * 8 + tl; const float tt = (float)t / (float)(L - 1); const float val = acc[tl][e] * __expf(-tt * delta);
                    const int y = dir ? L + t + 1 : L - t; if (y < 2 * L) Gc[y] = (bf16_t)f2bf(val); }
                if (tb == 0 && dir == 0) Gc[0] = 0; }
        }
        __syncthreads();
    }
}
__device__ __forceinline__ int mod_row(int r) { return r < MCTX ? 0 : 1 + ((r - MCTX) >> 10); }
__device__ __forceinline__ void mod0_phase(KP p) {
    const int tid = opaque_tid(), wave = tid >> 6, lane = tid & 63, gw = blockIdx.x * 8 + wave, NGW = gridDim.x * 8;
    const float* mod = (const float*)(p->ws + WS_MOD); bf16_t* H = (bf16_t*)(p->ws + WS_H);
#pragma unroll 1
    for (int r = gw; r < MROWS; r += NGW) {
        const float* x = r < MCTX ? p->in[I_XP] + (size_t)r * DM : p->in[I_XS] + (size_t)(r - MCTX) * DM;
        const float* mr = mod + (size_t)mod_row(r) * 12288;
        f32x4 xv[8], shv[8], scv[8];
#pragma unroll
        for (int j = 0; j < 8; ++j) { const int c = (lane + 64 * j) * 4; xv[j] = *(const f32x4*)(x + c); shv[j] = *(const f32x4*)(mr + c); scv[j] = *(const f32x4*)(mr + 2048 + c); }
#pragma unroll
        for (int j = 0; j < 8; ++j) { const int c = (lane + 64 * j) * 4;
            const f32x4 h = xv[j] * (scv[j] + 1.0f) + shv[j]; u32x2 o; o.x = pk2(h[0], h[1]); o.y = pk2(h[2], h[3]); *(u32x2*)(H + (size_t)r * DM + c) = o; }
    }
}
__device__ __forceinline__ void ln_phase(KP p, const float* lw, const float* lb, const float* mod_next, float* stats_out, float* Yout) {
    const int tid = opaque_tid(), wave = tid >> 6, lane = tid & 63, gw = blockIdx.x * 8 + wave, NGW = gridDim.x * 8;
    const bf16_t* YB = (const bf16_t*)(p->ws + WS_YB); bf16_t* H = (bf16_t*)(p->ws + WS_H);
    f32x4 wreg[8], breg[8];
#pragma unroll
    for (int j = 0; j < 4; ++j) { const int c = (lane + 64 * j) * 8; wreg[2 * j] = *(const f32x4*)(lw + c); wreg[2 * j + 1] = *(const f32x4*)(lw + c + 4); breg[2 * j] = *(const f32x4*)(lb + c); breg[2 * j + 1] = *(const f32x4*)(lb + c + 4); }
    u32x4 nx[4];
    if (gw < MROWS) {
#pragma unroll
        for (int j = 0; j < 4; ++j) nx[j] = *(const u32x4*)(YB + (size_t)gw * DM + (lane + 64 * j) * 8); }
#pragma unroll 1
    for (int r = gw; r < MROWS; r += NGW) {
        f32x4 v[8]; float s = 0.f;
#pragma unroll
        for (int j = 0; j < 4; ++j) { const u32x4 xw = nx[j];
            v[2 * j][0] = bflo(xw.x); v[2 * j][1] = bfhi(xw.x); v[2 * j][2] = bflo(xw.y); v[2 * j][3] = bfhi(xw.y);
            v[2 * j + 1][0] = bflo(xw.z); v[2 * j + 1][1] = bfhi(xw.z); v[2 * j + 1][2] = bflo(xw.w); v[2 * j + 1][3] = bfhi(xw.w); }
#pragma unroll
        for (int j = 0; j < 8; ++j) s += (v[j][0] + v[j][1]) + (v[j][2] + v[j][3]);
        if (r + NGW < MROWS) {
#pragma unroll
            for (int j = 0; j < 4; ++j) nx[j] = *(const u32x4*)(YB + (size_t)(r + NGW) * DM + (lane + 64 * j) * 8); }
        const float mean = wave_sum(s) * (1.f / DM); float q = 0.f;
#pragma unroll
        for (int j = 0; j < 8; ++j) { v[j] = v[j] - mean; q += (v[j][0] * v[j][0] + v[j][1] * v[j][1]) + (v[j][2] * v[j][2] + v[j][3] * v[j][3]); }
        const float rstd = 1.0f / sqrtf(wave_sum(q) * (1.f / DM) + 1e-6f);
        const float* mr = mod_next ? mod_next + (size_t)mod_row(r) * 12288 : nullptr;
        if (stats_out && lane == 0) { stats_out[2 * (size_t)r] = mean; stats_out[2 * (size_t)r + 1] = rstd; }
        f32x4 shv[8], scv[8];
        if (mod_next) {
#pragma unroll
            for (int j = 0; j < 4; ++j) { const int c = (lane + 64 * j) * 8; shv[2 * j] = *(const f32x4*)(mr + c); shv[2 * j + 1] = *(const f32x4*)(mr + c + 4); scv[2 * j] = *(const f32x4*)(mr + 2048 + c); scv[2 * j + 1] = *(const f32x4*)(mr + 2048 + c + 4); } }
#pragma unroll
        for (int j = 0; j < 4; ++j) { const int c = (lane + 64 * j) * 8;
            const f32x4 o0 = v[2 * j] * rstd * wreg[2 * j] + breg[2 * j], o1 = v[2 * j + 1] * rstd * wreg[2 * j + 1] + breg[2 * j + 1];
            if (Yout) { *(f32x4*)(Yout + (size_t)r * DM + c) = o0; *(f32x4*)(Yout + (size_t)r * DM + c + 4) = o1; }
            if (mod_next) { const f32x4 h0 = o0 * (scv[2 * j] + 1.0f) + shv[2 * j], h1 = o1 * (scv[2 * j + 1] + 1.0f) + shv[2 * j + 1];
                u32x4 ob; ob.x = pk2(h0[0], h0[1]); ob.y = pk2(h0[2], h0[3]); ob.z = pk2(h1[0], h1[1]); ob.w = pk2(h1[2], h1[3]); *(u32x4*)(H + (size_t)r * DM + c) = ob; } }
    }
}
__device__ __forceinline__ void unpack8(const u32x4 a, float* d) { d[0] = bflo(a.x); d[1] = bfhi(a.x); d[2] = bflo(a.y); d[3] = bfhi(a.y); d[4] = bflo(a.z); d[5] = bfhi(a.z); d[6] = bflo(a.w); d[7] = bfhi(a.w); }
__device__ __forceinline__ void gate_phase(KP p, int l) {
    const bf16_t* __restrict__ UP = (const bf16_t*)(p->ws + WS_UP); bf16_t* __restrict__ ACT = (bf16_t*)(p->ws + WS_ACT);
    const float* cw = p->in[I_FFNCONV] + (size_t)l * 3 * NUP;
    const int gt = blockIdx.x * 512 + opaque_tid(), GT = gridDim.x * 512;
    for (int u = gt; u < 704 * 384; u += GT) {
        const int rs = u / 704, cg = u - rs * 704, c0 = cg * 8, r0 = rs * 32;
        const int Lseq = r0 < MCTX ? 256 : 1024; const int t0 = (r0 < MCTX ? r0 : r0 - MCTX) & (Lseq - 1);
        float wg[3][8], wu[3][8];
#pragma unroll
        for (int k = 0; k < 3; ++k) { const f32x4 a0 = *(const f32x4*)(cw + k * NUP + c0), a1 = *(const f32x4*)(cw + k * NUP + c0 + 4), b0 = *(const f32x4*)(cw + k * NUP + DFF + c0), b1 = *(const f32x4*)(cw + k * NUP + DFF + c0 + 4);
#pragma unroll
            for (int e = 0; e < 4; ++e) { wg[k][e] = a0[e]; wg[k][4 + e] = a1[e]; wu[k][e] = b0[e]; wu[k][4 + e] = b1[e]; } }
        float gp[8], gc[8], gn[8], up_[8], uc[8], un[8];
        const u32x4 zero4 = (u32x4){0u, 0u, 0u, 0u};
        const bf16_t* base = UP + (size_t)r0 * NUP + c0;
        { const u32x4 a = t0 > 0 ? *(const u32x4*)(base - NUP) : zero4, b2 = t0 > 0 ? *(const u32x4*)(base - NUP + DFF) : zero4; unpack8(a, gp); unpack8(b2, up_);
          const u32x4 c = *(const u32x4*)base, d = *(const u32x4*)(base + DFF); unpack8(c, gc); unpack8(d, uc); }
        u32x4 ng[4], nu[4];
#pragma unroll
        for (int k = 0; k < 4; ++k) { const bool valid = t0 + k + 1 < Lseq; const bf16_t* s = base + (size_t)(k + 1) * NUP;
            ng[k] = valid ? *(const u32x4*)s : zero4; nu[k] = valid ? *(const u32x4*)(s + DFF) : zero4; }
#pragma unroll 1
        for (int i0 = 0; i0 < 32; i0 += 4) {
            u32x4 rg[4], ru[4];
#pragma unroll
            for (int k = 0; k < 4; ++k) { rg[k] = ng[k]; ru[k] = nu[k]; }
            if (i0 + 4 < 32) {
#pragma unroll
                for (int k = 0; k < 4; ++k) { const bool valid = t0 + i0 + 4 + k + 1 < Lseq; const bf16_t* s = base + (size_t)(i0 + 4 + k + 1) * NUP;
                    ng[k] = valid ? *(const u32x4*)s : zero4; nu[k] = valid ? *(const u32x4*)(s + DFF) : zero4; } }
#pragma unroll
            for (int k = 0; k < 4; ++k) { unpack8(rg[k], gn); unpack8(ru[k], un);
                float o[8];
#pragma unroll
                for (int e = 0; e < 8; ++e) { const float G = wg[0][e] * gp[e] + wg[1][e] * gc[e] + wg[2][e] * gn[e], U = wu[0][e] * up_[e] + wu[1][e] * uc[e] + wu[2][e] * un[e];
                    o[e] = silu_f(G) * U; gp[e] = gc[e]; gc[e] = gn[e]; up_[e] = uc[e]; uc[e] = un[e]; }
                u32x4 w; w.x = pk2(o[0], o[1]); w.y = pk2(o[2], o[3]); w.z = pk2(o[4], o[5]); w.w = pk2(o[6], o[7]);
                *(u32x4*)(ACT + (size_t)(r0 + i0 + k) * DFF + c0) = w; }
        }
    }
}
__device__ __forceinline__ void gate_fixup_phase(KP p, int l) {
    const bf16_t* __restrict__ ST = (const bf16_t*)(p->ws + WS_STASH); bf16_t* __restrict__ ACT = (bf16_t*)(p->ws + WS_ACT);
    const float* cw = p->in[I_FFNCONV] + (size_t)l * 3 * NUP;
    const int gt = blockIdx.x * 512 + opaque_tid(), GT = gridDim.x * 512;
    for (int u = gt; u < 384 * 704; u += GT) {
        const int br = u / 704, cg = u - br * 704, c0 = cg * 8, grp = br >> 1, which = br & 1, r = grp * 64 + (which ? 63 : 0);
        const int Lseq = r < MCTX ? 256 : 1024; const int t = (r < MCTX ? r : r - MCTX) & (Lseq - 1);
        const u32x4 zero4 = (u32x4){0u, 0u, 0u, 0u};
        const bf16_t* sp; const bf16_t* sc; const bf16_t* sn; bool vp, vn;
        if (which == 0) { sc = ST + (size_t)((grp * 4 + 0) * 2) * DFF; sn = ST + (size_t)((grp * 4 + 1) * 2) * DFF; sp = ST + (size_t)(((grp - 1) * 4 + 3) * 2) * DFF; vp = t > 0; vn = true; }
        else { sc = ST + (size_t)((grp * 4 + 3) * 2) * DFF; sp = ST + (size_t)((grp * 4 + 2) * 2) * DFF; sn = ST + (size_t)(((grp + 1) * 4 + 0) * 2) * DFF; vp = true; vn = t < Lseq - 1; }
        float gp[8], gc[8], gn[8], up_[8], uc[8], un[8];
        unpack8(vp ? *(const u32x4*)(sp + c0) : zero4, gp); unpack8(vp ? *(const u32x4*)(sp + DFF + c0) : zero4, up_);
        unpack8(*(const u32x4*)(sc + c0), gc); unpack8(*(const u32x4*)(sc + DFF + c0), uc);
        unpack8(vn ? *(const u32x4*)(sn + c0) : zero4, gn); unpack8(vn ? *(const u32x4*)(sn + DFF + c0) : zero4, un);
        float wgv[3][8], wuv[3][8];
#pragma unroll
        for (int k = 0; k < 3; ++k) { const f32x4 a0 = *(const f32x4*)(cw + k * NUP + c0), a1 = *(const f32x4*)(cw + k * NUP + c0 + 4), b0 = *(const f32x4*)(cw + k * NUP + DFF + c0), b1 = *(const f32x4*)(cw + k * NUP + DFF + c0 + 4);
#pragma unroll
            for (int e = 0; e < 4; ++e) { wgv[k][e] = a0[e]; wgv[k][4 + e] = a1[e]; wuv[k][e] = b0[e]; wuv[k][4 + e] = b1[e]; } }
        float o[8];
#pragma unroll
        for (int e = 0; e < 8; ++e) { const float G = wgv[0][e] * gp[e] + wgv[1][e] * gc[e] + wgv[2][e] * gn[e];
            const float U = wuv[0][e] * up_[e] + wuv[1][e] * uc[e] + wuv[2][e] * un[e]; o[e] = silu_f(G) * U; }
        u32x4 w; w.x = pk2(o[0], o[1]); w.y = pk2(o[2], o[3]); w.z = pk2(o[4], o[5]); w.w = pk2(o[6], o[7]);
        *(u32x4*)(ACT + (size_t)r * DFF + c0) = w;
    }
}
__device__ __forceinline__ void prep_phase(KP p, int l) {
    const int tid = opaque_tid(), wave = tid >> 6, lane = tid & 63, gw = blockIdx.x * 8 + wave, NGW = gridDim.x * 8;
    const int gt = blockIdx.x * 512 + tid, GT = gridDim.x * 512;
    const bf16_t* PROJ = (const bf16_t*)(p->ws + WS_PROJ);
    bf16_t* QN = (bf16_t*)(p->ws + WS_QN); bf16_t* KBL = (bf16_t*)(p->ws + WS_KBL); bf16_t* VBL = (bf16_t*)(p->ws + WS_VBL); bf16_t* KBC = (bf16_t*)(p->ws + WS_KBC); bf16_t* VBC = (bf16_t*)(p->ws + WS_VBC);
    const float* qnw = p->in[I_QN] + l * 128; const float* knw = p->in[I_KN] + l * 128;
    const float invf = exp2f(-(float)(lane & 31) * (13.287712379549449f / 32.0f));
    const float qw0 = qnw[lane], qw1 = qnw[lane + 64], kw0 = knw[lane], kw1 = knw[lane + 64];
    bf16_t n0[12], n1[12];
    if (gw < MROWS) {
#pragma unroll
        for (int hh = 0; hh < 12; ++hh) { n0[hh] = PROJ[(size_t)gw * NIN + hh * 128 + lane]; n1[hh] = PROJ[(size_t)gw * NIN + hh * 128 + 64 + lane]; } }
#pragma unroll 1
    for (int r = gw; r < MROWS; r += NGW) {
        const bf16_t* src = PROJ + (size_t)r * NIN;
        bf16_t a0[12], a1[12];
#pragma unroll
        for (int hh = 0; hh < 12; ++hh) { a0[hh] = n0[hh]; a1[hh] = n1[hh]; }
        if (r + NGW < MROWS) {
#pragma unroll
            for (int hh = 0; hh < 12; ++hh) { n0[hh] = src[(size_t)NGW * NIN + hh * 128 + lane]; n1[hh] = src[(size_t)NGW * NIN + hh * 128 + 64 + lane]; } }
        const bool lat = r >= MCTX; const int rl = lat ? r - MCTX : r; const int b = lat ? rl >> 10 : rl >> 8; const int t = lat ? rl & 1023 : rl & 255;
        float cs = 1.f, sn = 0.f;
        if (lat) { const float pos = (lane < 32) ? (float)(t >> 6) : (float)(t & 63); const float ang = pos * invf; cs = cosf(ang); sn = sinf(ang); }
#pragma unroll
        for (int hh = 0; hh < 10; ++hh) {
            const float v0 = bf2f(a0[hh]), v1 = bf2f(a1[hh]);
            const float ss = wave_sum(v0 * v0 + v1 * v1); const float rinv = 1.0f / sqrtf(ss * (1.f / 128.f) + 1e-6f);
            const float y0 = v0 * rinv * (hh < 8 ? qw0 : kw0), y1 = v1 * rinv * (hh < 8 ? qw1 : kw1);
            const float o0 = y0 * cs - y1 * sn, o1 = y0 * sn + y1 * cs;
            if (hh < 8) { bf16_t* d = QN + (size_t)r * 1024 + hh * 128; d[lane] = (bf16_t)f2bf(o0); d[lane + 64] = (bf16_t)f2bf(o1); }
            else { const int kvh = hh - 8;
                if (lat) { bf16_t* dk = KBL + ((size_t)(b * 2 + kvh) * 1536 + 512 + t) * 128; bf16_t* dv = VBL + ((size_t)(b * 2 + kvh) * 1536 + 512 + t) * 128;
                    dk[lane] = (bf16_t)f2bf(o0); dk[lane + 64] = (bf16_t)f2bf(o1); dv[lane] = a0[hh + 2]; dv[lane + 64] = a1[hh + 2]; }
                else { bf16_t* dk = KBC + ((size_t)(b * 2 + kvh) * 256 + t) * 128; bf16_t* dv = VBC + ((size_t)(b * 2 + kvh) * 256 + t) * 128;
                    dk[lane] = (bf16_t)f2bf(y0); dk[lane + 64] = (bf16_t)f2bf(y1); dv[lane] = a0[hh + 2]; dv[lane + 64] = a1[hh + 2];
                    float* ck = p->out + OUT_CK + ((size_t)((b * 2 + l) * 2 + kvh) * 256 + t) * 128; float* cv = p->out + OUT_CV + ((size_t)((b * 2 + l) * 2 + kvh) * 256 + t) * 128;
                    ck[lane] = y0; ck[lane + 64] = y1; cv[lane] = bf2f(a0[hh + 2]); cv[lane + 64] = bf2f(a1[hh + 2]); } }
        }
    }
    for (int u = gt; u < 8 * 2 * 512 * 16 * 2; u += GT) {
        const int kv = u & 1, e = u >> 1; const int cgp = e & 15, j = (e >> 4) & 511, kvh = (e >> 13) & 1, b = e >> 14;
        const float* src = p->in[kv ? I_CV : I_CK] + ((size_t)((b * 2 + l) * 2 + kvh) * 512 + j) * 128 + cgp * 8;
        const f32x4 a = *(const f32x4*)src, c = *(const f32x4*)(src + 4);
        u32x4 o; o.x = pk2(a[0], a[1]); o.y = pk2(a[2], a[3]); o.z = pk2(c[0], c[1]); o.w = pk2(c[2], c[3]);
        *(u32x4*)((kv ? VBL : KBL) + ((size_t)(b * 2 + kvh) * 1536 + j) * 128 + cgp * 8) = o;
    }
    bf16_t* KEL = (bf16_t*)(p->ws + WS_KEL); bf16_t* VEL = (bf16_t*)(p->ws + WS_VEL); bf16_t* KEC = (bf16_t*)(p->ws + WS_KEC); bf16_t* VEC = (bf16_t*)(p->ws + WS_VEC);
    for (int u = gt; u < 8 * 4 * 1280 * 16; u += GT) {
        const int cgp = u & 15; const int e = u >> 4; const int i = e % 1280, bh = e / 1280, h = bh & 3, b = bh >> 2;
        u32x4 ko, vo;
        if (i < 256) { const int dd = i & 127; ko = (u32x4){0u, 0u, 0u, 0u};
            if ((dd >> 3) == cgp) { const unsigned one = (dd & 1) ? 0x3F800000u : 0x00003F80u; const int wsel = (dd & 7) >> 1; ko.x = wsel == 0 ? one : 0u; ko.y = wsel == 1 ? one : 0u; ko.z = wsel == 2 ? one : 0u; ko.w = wsel == 3 ? one : 0u; }
            const float* st = p->in[I_ST] + ((size_t)(((b * 2 + l) * 2 + (i >> 7)) * 4 + h) * 128 + dd) * 128 + cgp * 8;
            const f32x4 a = *(const f32x4*)st, c = *(const f32x4*)(st + 4);
            vo.x = pk2(a[0], a[1]); vo.y = pk2(a[2], a[3]); vo.z = pk2(c[0], c[1]); vo.w = pk2(c[2], c[3]); }
        else { const bf16_t* src = PROJ + (size_t)(MCTX + b * 1024 + (i - 256)) * NIN + 2048 + h * 128 + cgp * 8;
            ko = *(const u32x4*)src; vo = *(const u32x4*)(src + 512); }
        *(u32x4*)(KEL + (size_t)e * 128 + cgp * 8) = ko; *(u32x4*)(VEL + (size_t)e * 128 + cgp * 8) = vo;
    }
    for (int u = gt; u < 16 * 4 * 256 * 16; u += GT) {
        const int cgp = u & 15; const int e = u >> 4; const int t = e & 255, bh = e >> 8, h = bh & 3, b = bh >> 2;
        const bf16_t* src = PROJ + (size_t)(b * 256 + t) * NIN + 2048 + h * 128 + cgp * 8;
        *(u32x4*)(KEC + (size_t)e * 128 + cgp * 8) = *(const u32x4*)src; *(u32x4*)(VEC + (size_t)e * 128 + cgp * 8) = *(const u32x4*)(src + 512);
    }
    bf16_t* HYT = (bf16_t*)(p->ws + WS_HYT); const float* hc = p->in[I_HYCONV] + (size_t)l * 3 * 1536;
    for (int u = gw; u < 192 * 24; u += NGW) {
        const int rb = u / 24, cb = u - rb * 24, ch = cb * 64 + lane, r0 = rb * 64;
        const int Lseq = r0 < MCTX ? 256 : 1024; const int t0 = (r0 < MCTX ? r0 : r0 - MCTX) & (Lseq - 1);
        const float w0 = hc[ch], w1 = hc[1536 + ch], w2 = hc[3072 + ch];
        const bf16_t* src = PROJ + (size_t)r0 * NIN + 3584 + ch;
        bf16_t raw[66];
#pragma unroll
        for (int i = 0; i < 66; ++i) raw[i] = src[(long)(i - 1) * NIN];
        float xp = t0 > 0 ? bf2f(raw[0]) : 0.f, xc = bf2f(raw[1]);
        unsigned pk[32];
#pragma unroll
        for (int i = 0; i < 64; i += 2) {
            const float xn = bf2f(raw[i + 2]);
            const float ya = w0 * xp + w1 * xc + w2 * xn;
            const float xn2 = (i < 62 || t0 + 64 < Lseq) ? bf2f(raw[i + 3]) : 0.f;
            const float yb = w0 * xc + w1 * xn + w2 * xn2;
            pk[i >> 1] = pk2(ya, yb); xp = xn; xc = xn2;
        }
        bf16_t* dst = HYT + (size_t)ch * MROWS + r0;
#pragma unroll
        for (int i = 0; i < 8; ++i) { u32x4 o; o.x = pk[4 * i]; o.y = pk[4 * i + 1]; o.z = pk[4 * i + 2]; o.w = pk[4 * i + 3]; *(u32x4*)(dst + 8 * i) = o; }
    }
}
template <int TPW, int NB>
__device__ __forceinline__ void hyena_item(KP p, LAS unsigned char* lds, int c, int l) {
    constexpr int L = TPW * 128, CS = 2 * L + 128, RS = L + 16, ROWBASE = (NB == 8) ? MCTX : 0;
    LAS bf16_t* gc = (LAS bf16_t*)lds; LAS bf16_t* U0 = gc + 8 * CS; LAS bf16_t* U1 = U0 + NB * RS;
    const int tid = opaque_tid(), w = tid >> 6, lane = tid & 63, i = lane & 15, kq = lane >> 4;
    const bf16_t* hyt = (const bf16_t*)(p->ws + WS_HYT) + (size_t)c * MROWS + ROWBASE;
    const bf16_t* GF = (const bf16_t*)(p->ws + (NB == 8 ? WS_GF1 : WS_GF0) + (size_t)l * GF_LSTRIDE);
    bf16_t* CC = (bf16_t*)(p->ws + WS_CONCAT);
    for (int idx = tid * 8; idx < NB * L; idx += 512 * 8) { const int b = idx / L, m = idx - b * L; *(LAS u32x4*)(U0 + b * RS + m) = *(const u32x4*)(hyt + idx); }
#pragma unroll 1
    for (int o = 0; o < 2; ++o) {
        const bf16_t* G = GF + ((size_t)o * 512 + c) * (2 * L);
        { constexpr int NCH = 2 * L / 8;
          for (int idx = tid; idx < NCH * 8; idx += 512) { const int ch = idx % NCH, s = idx / NCH; const u32x4 gv = *(const u32x4*)(G + ch * 8);
              LAS bf16_t* d = gc + s * CS + 8 * ((s & 1) + 4 * (s >> 1)) + ch * 8 + s;
              d[0] = (bf16_t)(gv.x & 0xffffu); d[1] = (bf16_t)(gv.x >> 16); d[2] = (bf16_t)(gv.y & 0xffffu); d[3] = (bf16_t)(gv.y >> 16);
              d[4] = (bf16_t)(gv.z & 0xffffu); d[5] = (bf16_t)(gv.z >> 16); d[6] = (bf16_t)(gv.w & 0xffffu); d[7] = (bf16_t)(gv.w >> 16); }
          if (tid < 8) { for (int y = 0; y < tid; ++y) gc[tid * CS + 8 * ((tid & 1) + 4 * (tid >> 1)) + y] = (bf16_t)0; } }
        __syncthreads();
        const LAS bf16_t* Uin = o ? U1 : U0;
        f32x4 acc[TPW];
#pragma unroll
        for (int t = 0; t < TPW; ++t) acc[t] = (f32x4){0.f, 0.f, 0.f, 0.f};
        const LAS bf16_t* bp = Uin + (i & (NB - 1)) * RS + kq * 8;
        const LAS bf16_t* ap = gc + (i & 7) * CS + 8 * ((i & 1) + 4 * ((i & 7) >> 1)) + kq * 8 - (i & 8) + L - w * TPW * 16;
#pragma unroll 4
        for (int m0 = 0; m0 < L; m0 += 32) {
            const bf16x8 B = *(const LAS bf16x8*)(bp + m0);
#pragma unroll
            for (int t = 0; t < TPW; ++t) { const bf16x8 A = *(const LAS bf16x8*)(ap + m0 - t * 16); acc[t] = __builtin_amdgcn_mfma_f32_16x16x32_bf16(A, B, acc[t], 0, 0, 0); }
        }
        const float bias = p->in[I_HYBIAS][(l * 2 + o) * 512 + c];
        const int b = i, rq = kq;
        if (b < NB) {
            u32x2 xga[TPW];
#pragma unroll
            for (int t = 0; t < TPW; ++t) xga[t] = *(const u32x2*)(hyt + (size_t)(1 + o) * 512 * MROWS + b * L + (w * TPW + t) * 16 + rq * 4);
#pragma unroll
            for (int t = 0; t < TPW; ++t) { const int n = (w * TPW + t) * 16 + rq * 4;
                const u32x2 vin = *(const LAS u32x2*)(Uin + b * RS + n); const u32x2 xg = xga[t];
                const float z0 = bflo(xg.x) * (acc[t][0] + bflo(vin.x) * bias), z1 = bfhi(xg.x) * (acc[t][1] + bfhi(vin.x) * bias),
                            z2 = bflo(xg.y) * (acc[t][2] + bflo(vin.y) * bias), z3 = bfhi(xg.y) * (acc[t][3] + bfhi(vin.y) * bias);
                if (o == 0) { u32x2 zo; zo.x = pk2(z0, z1); zo.y = pk2(z2, z3); *(LAS u32x2*)(U1 + b * RS + n) = zo; }
                else { bf16_t* d = CC + (size_t)(ROWBASE + b * L + n) * DM + 1536 + c; d[0] = (bf16_t)f2bf(z0); d[DM] = (bf16_t)f2bf(z1); d[2 * DM] = (bf16_t)f2bf(z2); d[3 * DM] = (bf16_t)f2bf(z3); } }
        }
        __syncthreads();
    }
}
__device__ __forceinline__ float log2_sigmoid(float x) { return -log1pf(__expf(-x)) * 1.4426950408889634f; }
__device__ __forceinline__ void mix_phase(KP p, LAS unsigned char* ldsl, char* ldsg, int l) {
    unsigned* ctr = (unsigned*)(p->ws + WS_CTL) + 64 * (1 + l);
    LAS int* s_item = (LAS int*)(ldsl + LDS_ITEM_OFF);
    const bf16_t* PROJ = (const bf16_t*)(p->ws + WS_PROJ); bf16_t* CC = (bf16_t*)(p->ws + WS_CONCAT);
    const bf16_t* QN = (const bf16_t*)(p->ws + WS_QN);
    const float* rd = p->in[I_RDEC] + l * 8;
    for (;;) {
        if (threadIdx.x == 0) *s_item = (int)atomicAdd(ctr, 1u);
        __syncthreads();
        const int it = *s_item;
        __syncthreads();
#ifdef PROBE_DUP_LO
        if (it >= 1664 + (PROBE_DUP_HI - PROBE_DUP_LO)) break;
        const int it_orig = it; (void)it_orig;
#define it (it_orig >= 1664 ? it_orig - 1664 + PROBE_DUP_LO : it_orig)
#else
        if (it >= 1664) {
#ifdef PROBE_TAIL
            if (threadIdx.x == 0) { const unsigned t = (unsigned)__builtin_amdgcn_s_memrealtime(); unsigned* w = (unsigned*)(p->ws + WS_CTL) + 64 * (8 + 2 * l); atomicMin(w, t); atomicMax(w + 64, t); }
#endif
            break; }
#endif
        if ((it >= 128 && it < 384) || (it >= 896 && it < 1024)) {
            const bool lat = it < 384; const int j = lat ? it - 128 : it - 896;
            const int b = lat ? j >> 5 : j >> 3, h = lat ? (j >> 2) & 7 : j & 7, qb = lat ? j & 3 : 0;
            const size_t row = lat ? (size_t)(MCTX + b * 1024 + qb * 256) : (size_t)b * 256; const int seq = lat ? 1536 : 256;
            const size_t kvo = (size_t)(b * 2 + (h >> 2)) * seq * 128;
            att::attn_dense_body<1024, 128, 2048>(QN + row * 1024 + h * 128, (const bf16_t*)(p->ws + (lat ? WS_KBL : WS_KBC)) + kvo, (const bf16_t*)(p->ws + (lat ? WS_VBL : WS_VBC)) + kvo,
                CC + row * DM + h * 128, seq, ldsg);
        } else if (it < 128 || (it >= 1024 && it < 1088)) {
            const bool lat = it < 128; const int j = lat ? it : it - 1024;
            const int b = lat ? j >> 4 : j >> 2, h = lat ? (j >> 2) & 3 : j & 3, qb = lat ? j & 3 : 0;
            const size_t row = lat ? (size_t)(MCTX + b * 1024 + qb * 256) : (size_t)b * 256; const int seq = lat ? 1280 : 256;
            const size_t kvo = (size_t)(b * 4 + h) * seq * 128;
            att::retn_body<0, NIN>(PROJ + row * NIN + 1536 + h * 128, (const bf16_t*)(p->ws + (lat ? WS_KEL : WS_KEC)) + kvo, (const bf16_t*)(p->ws + (lat ? WS_VEL : WS_VEC)) + kvo,
                seq, lat ? 4 : 0, qb * 256, lat ? 1024 : 256, log2_sigmoid(rd[h]), log2_sigmoid(rd[4 + h]), PROJ + row * NIN + 3072 + h * 128, CC + row * DM + 1024 + h * 128, nullptr, ldsg);
        } else if (it < 896) {
            hyena_item<8, 8>(p, ldsl, it - 384, l);
        } else if (it < 1152) {
            const int j = it - 1088, b = j >> 2, h = j & 3;
            att::retn_body<1, NIN>((const bf16_t*)(p->ws + WS_IDQ), (const bf16_t*)(p->ws + WS_KEC) + (size_t)(b * 4 + h) * 256 * 128, (const bf16_t*)(p->ws + WS_VEC) + (size_t)(b * 4 + h) * 256 * 128,
                256, 0, 0, 256, log2_sigmoid(rd[h]), log2_sigmoid(rd[4 + h]), nullptr, nullptr, p->out + OUT_ST + (size_t)((b * 2 + l) * 2 * 4 + h) * 16384, ldsg);
        } else {
            hyena_item<2, 16>(p, ldsl, it - 1152, l);
        }
    }
}
#ifdef PROBE_DUP_LO
#undef it
#endif
__device__ __forceinline__ void p0_phase(KP p, LAS unsigned char* ldsl) {
    unsigned* ctr = (unsigned*)(p->ws + WS_CTL) + 64 * 3;
    LAS int* s_item = (LAS int*)(ldsl + LDS_ITEM_OFF);
    for (;;) {
        __syncthreads();
        if (threadIdx.x == 0) *s_item = (int)atomicAdd(ctr, 1u);
        __syncthreads();
        const int it = *s_item;
        if (it >= 192 + 320 + T_IN / 8) break;
        if (it < 192) adaln_item(p, ldsl, it);
        else if (it < 512) filter_items(p, ldsl, (it - 192) / 160, (it - 192) % 160, (it - 192) % 160 + 1, 1);
        else convert_block_item(p, ldsl, 0, (it - 512) * 8);
    }
    __syncthreads();
}
__device__ __forceinline__ void side_work(KP p, LAS unsigned char* ldsl, int layer, int limit) {
    unsigned* ctr = (unsigned*)(p->ws + WS_CTL) + 64 * (layer ? 4 : 5);
    const int total = layer ? T_ALL / 8 : (T_ALL - T_IN) / 8;
    LAS int* s_item = (LAS int*)(ldsl + LDS_ITEM_OFF);
    for (;;) {
        __syncthreads();
        if (threadIdx.x == 0) { int v = total; if ((int)__hip_atomic_load(ctr, __ATOMIC_RELAXED, __HIP_MEMORY_SCOPE_AGENT) < limit) v = (int)atomicAdd(ctr, 1u); *s_item = v; }
        __syncthreads();
        const int it = *s_item;
        if (it >= total) break;
        convert_block_item(p, ldsl, layer, (layer ? 0 : T_IN) + it * 8);
    }
    __syncthreads();
}
#define XB_TMO      128
#define XB_XCNT(j)  (256  + 64 * (j))
#define XB_XSUB(j)  (1280 + 64 * (j))
#define XB_XGEN(j)  (2304 + 64 * (j))
#define XB_TOP      3328
#define XB_TOPGEN   3392
#define XCD_BAR_WORDS 3456
#define XB_SPIN_CAP (1u << 18)

__device__ __forceinline__ unsigned xb_ld(unsigned* p)              { return __hip_atomic_load(p, __ATOMIC_RELAXED, __HIP_MEMORY_SCOPE_AGENT); }
__device__ __forceinline__ unsigned xb_add(unsigned* p, unsigned v) { return __hip_atomic_fetch_add(p, v, __ATOMIC_RELAXED, __HIP_MEMORY_SCOPE_AGENT); }
__device__ __forceinline__ unsigned xb_xcc_id() { return (unsigned)__builtin_amdgcn_s_getreg((3 << 11) | 20) & 0xFu; }
#define XB_SPIN(cond, bar) do { unsigned _sp = 0; while (cond) { __builtin_amdgcn_s_sleep(1); \
    if ((++_sp & 255u) == 0u) { if (xb_ld(&(bar)[XB_TMO])) break; if (_sp > XB_SPIN_CAP) { atomicAdd(&(bar)[XB_TMO], 1u); break; } } } } while (0)

struct XcdBarrier {
    unsigned* bar; unsigned x;
    volatile LAS unsigned* st;
};

__device__ __forceinline__ XcdBarrier xcd_barrier_post(unsigned* bar, volatile LAS unsigned* st) {
    XcdBarrier b; b.bar = bar; b.x = xb_xcc_id(); b.st = st;
    if (threadIdx.x == 0) (void)xb_add(&bar[XB_XCNT(b.x)], 1u);
    return b;
}
__device__ __forceinline__ void xcd_barrier_complete(unsigned* bar, unsigned x, unsigned& nloc, unsigned& nx) {
    const unsigned G = gridDim.x * gridDim.y * gridDim.z;
    unsigned sum, cnt, mine, sp = 0u;
    for (;;) {
        sum = 0u; cnt = 0u; mine = 0u;
#pragma unroll
        for (unsigned j = 0; j < 16; ++j) { const unsigned c = xb_ld(&bar[XB_XCNT(j)]); sum += c; cnt += (c > 0u) ? 1u : 0u; mine = (j == x) ? c : mine; }
        if (sum == G) break;
        __builtin_amdgcn_s_sleep(1);
        if ((++sp & 255u) == 0u) { if (xb_ld(&bar[XB_TMO])) break; if (sp > XB_SPIN_CAP) { atomicAdd(&bar[XB_TMO], 1u); break; } }
    }
    nloc = mine > 0u ? mine : 1u; nx = cnt > 0u ? cnt : 1u;
}

__device__ __forceinline__ void xcd_barrier(const XcdBarrier& b) {
    asm volatile("s_waitcnt vmcnt(0)" ::: "memory");
    __syncthreads();
    if (threadIdx.x == 0) {
        unsigned* bar = b.bar;
        __builtin_amdgcn_s_waitcnt(0);
        unsigned nloc = b.st[0], nx = b.st[1];
        if (nloc == 0u) { xcd_barrier_complete(bar, b.x, nloc, nx); b.st[0] = nloc; b.st[1] = nx; }
        const unsigned old = xb_add(&bar[XB_XSUB(b.x)], 1u);
        const unsigned gen = old / nloc;
        if (old + 1u == (gen + 1u) * nloc) {
            __builtin_amdgcn_fence(__ATOMIC_RELEASE, "agent");
            asm volatile("s_waitcnt vmcnt(0)" ::: "memory");
            const unsigned og = xb_add(&bar[XB_TOP], 1u);
            const unsigned tg = og / nx;
            if (og + 1u == (tg + 1u) * nx) xb_add(&bar[XB_TOPGEN], 1u);
            else XB_SPIN(xb_ld(&bar[XB_TOPGEN]) == tg, bar);
            __builtin_amdgcn_fence(__ATOMIC_ACQUIRE, "agent");
            xb_add(&bar[XB_XGEN(b.x)], 1u);
            asm volatile("s_waitcnt vmcnt(0)" ::: "memory");
        } else {
            XB_SPIN(xb_ld(&bar[XB_XGEN(b.x)]) == gen, bar);
            __builtin_amdgcn_fence(__ATOMIC_ACQUIRE, "agent");
            asm volatile("s_waitcnt vmcnt(0)" ::: "memory");
        }
    }
    __syncthreads();
}

#ifndef SIDE_L0
#define SIDE_L0 500
#endif
#ifndef SIDE_L1
#define SIDE_L1 1100
#endif
#ifndef SIDE_L2
#define SIDE_L2 1504
#endif
#ifndef PROBE_MASK
#define PROBE_MASK 0
#endif
#ifndef PROBE_K
#define PROBE_K 2
#endif
#define PH_BEGIN(bit) do { if (PROBE_MASK && ((PROBE_MASK >> (bit)) & 1) && blockIdx.x == 0 && threadIdx.x == 0) *(LAS unsigned long long*)(ldsl + LDS_BYTES - 48) = __builtin_amdgcn_s_memrealtime(); } while (0)
#define PH_END(bit) do { if (PROBE_MASK && ((PROBE_MASK >> (bit)) & 1) && blockIdx.x == 0 && threadIdx.x == 0) *(LAS unsigned long long*)(ldsl + LDS_BYTES - 40) += __builtin_amdgcn_s_memrealtime() - *(LAS unsigned long long*)(ldsl + LDS_BYTES - 48); } while (0)
#define GSYNC() do { XcdBarrier b_; b_.bar = (unsigned*)(kp_fresh()->ws + WS_CTL + 65536); b_.x = xb_xcc_id(); b_.st = (volatile LAS unsigned*)(ldsl + LDS_BYTES - 32); xcd_barrier(b_); } while (0)
template <int l>
__device__ __forceinline__ void run_layer(LAS unsigned char* ldsl, unsigned char* lds, const int G) {
        PH_BEGIN(2);
        { KP q = kp_fresh(); pg8::Gemm g{(const bf16_t*)(q->ws + WS_H), (const bf16_t*)(q->ws + WS_WIN + wofs(l)), MROWS, NIN, DM}; pg8::StaticOrder S; S.init(MROWS, NIN, opaque_s(G), opaque_s((int)blockIdx.x));
          pg8::EpiBf16 E{(bf16_t*)(q->ws + WS_PROJ), NIN}; pg8::gemm_phase<pg8::EpiBf16, pg8::StaticOrder, true, true>(ldsl, g, S, E); }
        if (l == 0) side_work(kp_fresh(), ldsl, 0, 400);
        GSYNC();
        PH_END(2); PH_BEGIN(3);
        prep_phase(kp_fresh(), l);
        GSYNC();
        PH_END(3); PH_BEGIN(4);
        mix_phase(kp_fresh(), ldsl, (char*)lds, l);
        if (l == 0) side_work(kp_fresh(), ldsl, 0, 832);
        GSYNC();
        PH_END(4); PH_BEGIN(5);
        { KP q = kp_fresh(); pg8::Gemm g{(const bf16_t*)(q->ws + WS_CONCAT), (const bf16_t*)(q->ws + WS_WOUT + wofs(l)), MROWS, DM, DM}; pg8::StaticOrder S; S.init(MROWS, DM, opaque_s(G), opaque_s((int)blockIdx.x));
          pg8::EpiResid E{l == 0 ? q->in[I_XP] : nullptr, q->in[I_XS], (const bf16_t*)(q->ws + WS_YB), (bf16_t*)(q->ws + WS_YB), (const float*)(q->ws + WS_MOD) + (size_t)l * 9 * 12288 + 2 * 2048, 1.41421356237f,
                          (const float*)(q->ws + WS_STATS2), q->in[I_LN2W], q->in[I_LN2B]};
          pg8::gemm_phase<pg8::EpiResid, pg8::StaticOrder, true, true>(ldsl, g, S, E); }
        if (l == 0) { side_work(kp_fresh(), ldsl, 0, 1184); side_work(kp_fresh(), ldsl, 1, SIDE_L0); }
        GSYNC();
        PH_END(5); PH_BEGIN(6);
        { KP q = kp_fresh(); ln_phase(q, q->in[I_LN1W] + l * DM, q->in[I_LN1B] + l * DM, (const float*)(q->ws + WS_MOD) + (size_t)l * 9 * 12288 + 3 * 2048, (float*)(q->ws + WS_STATS1), nullptr); }
        GSYNC();
        PH_END(6); PH_BEGIN(7);
        { KP q = kp_fresh(); pg8::Gemm g{(const bf16_t*)(q->ws + WS_H), (const bf16_t*)(q->ws + WS_WUP + wofs(l)), MROWS, NUP, DM}; pg8::StaticOrder S; S.init(MROWS, NUP, opaque_s(G), opaque_s((int)blockIdx.x));
          pg8::EpiGate E{(bf16_t*)(q->ws + WS_ACT), (bf16_t*)(q->ws + WS_STASH), q->in[I_FFNCONV] + (size_t)l * 3 * NUP}; pg8::gemm_phase<pg8::EpiGate, pg8::StaticOrder, true, true>(ldsl, g, S, E); }
        if (l == 0) side_work(kp_fresh(), ldsl, 1, SIDE_L1);
        GSYNC();
        PH_END(7); PH_BEGIN(8);
        gate_fixup_phase(kp_fresh(), l);
        GSYNC();
        PH_END(8); PH_BEGIN(9);
        { KP q = kp_fresh(); pg8::Gemm g{(const bf16_t*)(q->ws + WS_ACT), (const bf16_t*)(q->ws + WS_WDN + wofs(l)), MROWS, DM, DFF}; pg8::StaticOrder S; S.init(MROWS, DM, opaque_s(G), opaque_s((int)blockIdx.x));
          pg8::EpiResid E{nullptr, nullptr, (const bf16_t*)(q->ws + WS_YB), (bf16_t*)(q->ws + WS_YB), (const float*)(q->ws + WS_MOD) + (size_t)l * 9 * 12288 + 5 * 2048, 1.41421356237f,
                          (const float*)(q->ws + WS_STATS1), q->in[I_LN1W] + l * DM, q->in[I_LN1B] + l * DM};
          pg8::gemm_phase<pg8::EpiResid, pg8::StaticOrder, true, true>(ldsl, g, S, E); }
        if (l == 0) side_work(kp_fresh(), ldsl, 1, SIDE_L2);
        GSYNC();
        PH_END(9); PH_BEGIN(10);
        { KP q = kp_fresh(); ln_phase(q, q->in[I_LN2W] + l * DM, q->in[I_LN2B] + l * DM, l == 0 ? (const float*)(q->ws + WS_MOD) + (size_t)9 * 12288 : nullptr, l == 0 ? (float*)(q->ws + WS_STATS2) : nullptr, l == 0 ? nullptr : q->out); }
        if (l == 0) { side_work(kp_fresh(), ldsl, 1, T_ALL / 8); GSYNC(); }
        PH_END(10);
}
__global__ void __launch_bounds__(512, 2) mega(Params p_unused) {
    extern __shared__ __attribute__((aligned(16))) unsigned char lds[];
    cg::grid_group grid = cg::this_grid();
    LAS unsigned char* ldsl = (LAS unsigned char*)lds;
    const int G = gridDim.x;
    KP p = kp_fresh();
    if (threadIdx.x < 2) ((volatile LAS unsigned*)(ldsl + LDS_BYTES - 32))[threadIdx.x] = 0u;
    __syncthreads();
    (void)xcd_barrier_post((unsigned*)(p->ws + WS_CTL + 65536), (volatile LAS unsigned*)(ldsl + LDS_BYTES - 32));
    if (PROBE_MASK && threadIdx.x == 0) *(LAS unsigned long long*)(ldsl + LDS_BYTES - 40) = 0ull;
    PH_BEGIN(0);
    { bf16_t* IDQ = (bf16_t*)(p->ws + WS_IDQ);
      for (int u = blockIdx.x * 512 + threadIdx.x; u < 256 * 128; u += G * 512) { const int n = u >> 7, j = u & 127; IDQ[(size_t)n * NIN + j] = (j == (n & 127)) ? (bf16_t)0x3F80 : (bf16_t)0; } }
    p0_phase(kp_fresh(), ldsl);
    if (kp_fresh()->pad != 0ull) grid.sync();
    GSYNC();
#ifdef PROBE_XSYNC
    for (int xs = 0; xs < PROBE_XSYNC; ++xs) GSYNC();
#endif
    PH_END(0); PH_BEGIN(1);
    mod0_phase(kp_fresh());
    GSYNC();
    PH_END(1);
    run_layer<0>(ldsl, lds, G);
    run_layer<1>(ldsl, lds, G);
#ifdef PROBE_TAIL
    GSYNC();
    if (blockIdx.x == 0 && threadIdx.x == 0) { const unsigned* w = (const unsigned*)(kp_fresh()->ws + WS_CTL);
        const unsigned t0v = __hip_atomic_load(w + 64 * 4, __ATOMIC_RELAXED, __HIP_MEMORY_SCOPE_AGENT), t1v = __hip_atomic_load(w + 64 * 5, __ATOMIC_RELAXED, __HIP_MEMORY_SCOPE_AGENT);
        const unsigned t2v = __hip_atomic_load(w + 64 * 6, __ATOMIC_RELAXED, __HIP_MEMORY_SCOPE_AGENT), t3v = __hip_atomic_load(w + 64 * 7, __ATOMIC_RELAXED, __HIP_MEMORY_SCOPE_AGENT);
        const unsigned long long want = (unsigned long long)PROBE_TAIL * ((t1v - t0v) + (t3v - t2v)); const unsigned long long s0 = __builtin_amdgcn_s_memrealtime();
        while (__builtin_amdgcn_s_memrealtime() - s0 < want) __builtin_amdgcn_s_sleep(32); }
#endif
    if (PROBE_MASK && blockIdx.x == 0 && threadIdx.x == 0) { const unsigned long long t0 = __builtin_amdgcn_s_memrealtime(), want = (unsigned long long)PROBE_K * *(LAS unsigned long long*)(ldsl + LDS_BYTES - 40);
        while (__builtin_amdgcn_s_memrealtime() - t0 < want) __builtin_amdgcn_s_sleep(32); }
}
extern "C" void kernel_launch(void* const* d_in, const int* in_sizes, int n_in, void* d_out, int out_size, void* d_ws, size_t ws_size, hipStream_t stream) {
    static int grid = 0;
    if (grid == 0) {
        if (n_in != 29 || out_size != 33554432 || ws_size < WS_END) { fprintf(stderr, "kernel_launch: unexpected shapes: n_in %d out %d ws %zu (need %zu)\n", n_in, out_size, ws_size, (size_t)WS_END); grid = -1; return; }
        int dev = 0, cus = 0, per_cu = 0;
        (void)hipGetDevice(&dev); (void)hipDeviceGetAttribute(&cus, hipDeviceAttributeMultiprocessorCount, dev);
        if (hipFuncSetAttribute((const void*)mega, hipFuncAttributeMaxDynamicSharedMemorySize, LDS_BYTES) != hipSuccess) { fprintf(stderr, "kernel_launch: hipFuncSetAttribute failed\n"); grid = -1; return; }
        if (hipOccupancyMaxActiveBlocksPerMultiprocessor(&per_cu, (const void*)mega, 512, LDS_BYTES) != hipSuccess || per_cu < 1) { fprintf(stderr, "kernel_launch: occupancy query says %d\n", per_cu); per_cu = 1; }
        (void)hipGetLastError();
        grid = cus > 0 ? cus : 256;
    }
    if (grid < 0) return;
    Params p{};
    for (int i = 0; i < 29; ++i) p.in[i] = (const float*)d_in[i];
    p.out = (float*)d_out; p.ws = (unsigned char*)d_ws; p.pad = 0ull;
    if (hipMemsetAsync((char*)d_ws + WS_CTL, 0, 2 * MiB, stream) != hipSuccess) { fprintf(stderr, "kernel_launch: hipMemsetAsync failed\n"); return; }
    void* args[] = {&p};
    const hipError_t e = hipLaunchCooperativeKernel((const void*)mega, dim3(grid), dim3(512), args, LDS_BYTES, stream);
    if (e != hipSuccess) fprintf(stderr, "kernel_launch: cooperative launch failed: %s (grid %d)\n", hipGetErrorString(e), grid);
}
```
